# Optimizing an MI355X kernel written in HIP

```python
import math
import jax, jax.numpy as jnp
from jax import lax
import numpy as np

D_MODEL = 1024
BATCH = 4
SEQ = 8192
DEPTH = 2
DEC_BATCH = 8
DEC_SEQ = 16
PAST_LEN = 1024

CHUNK = 64
EPS = 1e-6
A_WIDTH = 256
A_GROUPS = 4
A_GDIM = A_WIDTH // A_GROUPS
A_CHUNK = 128
B_WIDTH = 256
B_KW = 31
C_HEADS = 8
C_NOPE = 64
C_ROPE = 32
C_VDIM = 64
C_QRANK = 256
C_KVRANK = 128
C_WIDTH = C_HEADS * C_VDIM
ROPE_THETA = 10000.0
Q_BLOCK = 128
MEM_LEN = 256
MEM_HEADS = 4
MEM_HDIM = 128
MEM_WIDTH = MEM_HEADS * MEM_HDIM
D_FF = 4 * D_MODEL

IN_WIDTH = 2 * A_WIDTH + 2 * B_WIDTH + C_QRANK + C_KVRANK + C_ROPE
MIX_WIDTH = A_WIDTH + B_WIDTH + C_WIDTH

kernel_name = 'hybrid_streaming_encoder_step'


def _rmsnorm(x, g):
    xf = x.astype(jnp.float32)
    y = xf * lax.rsqrt(jnp.mean(xf * xf, axis=-1, keepdims=True) + EPS)
    return (y * g.astype(jnp.float32)).astype(x.dtype)


def _layernorm(x, g, b):
    xf = x.astype(jnp.float32)
    xc = xf - jnp.mean(xf, axis=-1, keepdims=True)
    y = xc * lax.rsqrt(jnp.mean(xc * xc, axis=-1, keepdims=True) + EPS)
    return (y * g.astype(jnp.float32) + b.astype(jnp.float32)).astype(x.dtype)


def _rope(x, pos):
    half = C_ROPE // 2
    inv = ROPE_THETA ** (-jnp.arange(half, dtype=jnp.float32) / half)
    ang = pos.astype(jnp.float32)[:, None] * inv[None, :]
    shape = (pos.shape[0],) + (1,) * (x.ndim - 3) + (half,)
    cos = jnp.cos(ang).reshape(shape)
    sin = jnp.sin(ang).reshape(shape)
    xf = x.astype(jnp.float32)
    x1, x2 = xf[..., :half], xf[..., half:]
    return jnp.concatenate([x1 * cos - x2 * sin, x1 * sin + x2 * cos], axis=-1).astype(x.dtype)


def _gmlp(u, v, g, ws, bs):
    b, t, _ = u.shape
    L = min(t, A_CHUNK)
    u = jax.nn.gelu(u, approximate=False)
    v = _rmsnorm(jax.nn.gelu(v, approximate=False), g)
    mask = jnp.tril(jnp.ones((A_CHUNK, A_CHUNK), dtype=bool))
    wm = jnp.where(mask[None], ws, jnp.zeros_like(ws))[:, :L, :L]
    vc = v.reshape(b, t // L, L, A_GROUPS, A_GDIM)
    mixed = jnp.einsum('gij,bcjgd->bcigd', wm, vc) + bs[:, :L].T[None, None, :, :, None]
    return u * mixed.reshape(b, t, A_WIDTH), v


def _conv_module(a, gate, hist, w, bias, ln_g, ln_b):
    z = a * jax.nn.sigmoid(gate)
    if hist is None:
        hist = jnp.zeros((z.shape[0], B_KW - 1, B_WIDTH), z.dtype)
    zp = jnp.concatenate([hist.astype(z.dtype), z], axis=1)
    y = lax.conv_general_dilated(zp, w[:, None, :].astype(z.dtype), window_strides=(1,), padding='VALID',
                                 dimension_numbers=('NWC', 'WIO', 'NWC'),
                                 feature_group_count=B_WIDTH) + bias
    y = jax.nn.silu(_layernorm(y, ln_g, ln_b))
    return y, zp[:, zp.shape[1] - (B_KW - 1):]


def _mla_attend(q_nope, q_rope, qpos, k_nope, k_rope, v, kpos):
    s = jnp.einsum('bqhd,bkhd->bhqk', q_nope, k_nope) + jnp.einsum('bqhr,bkr->bhqk', q_rope, k_rope)
    s = s.astype(jnp.float32) * (1.0 / math.sqrt(C_NOPE + C_ROPE))
    mask = (kpos[None, :] // CHUNK) <= (qpos[:, None] // CHUNK)
    s = jnp.where(mask[None, None], s, -1e30)
    p = jax.nn.softmax(s, axis=-1).astype(v.dtype)
    o = jnp.einsum('bhqk,bkhd->bqhd', p, v)
    return o.reshape(o.shape[0], o.shape[1], C_WIDTH)


def _mem_kv(mem, l, W):
    b, m, _ = mem.shape
    mn = _rmsnorm(mem, W['mem_norm_g'][l])
    k = _rmsnorm((mn @ W['w_mk'][l]).reshape(b, m, MEM_HEADS, MEM_HDIM), W['m_k_g'][l])
    v = (mn @ W['w_mv'][l]).reshape(b, m, MEM_HEADS, MEM_HDIM)
    return k, v


def _layer(x, l, W, mem_k, mem_v, conv_hist, lat_past, kr_past, start):
    b, t, _ = x.shape
    h = _rmsnorm(x, W['norm_mix_g'][l]) @ W['w_in'][l]
    c0 = 2 * A_WIDTH + 2 * B_WIDTH
    cuts = [A_WIDTH, 2 * A_WIDTH, 2 * A_WIDTH + B_WIDTH, c0, c0 + C_QRANK, c0 + C_QRANK + C_KVRANK]
    a_u, a_v, b_a, b_g, c_q, c_kv, c_kr = jnp.split(h, cuts, axis=-1)
    y_a, v_rows = _gmlp(a_u, a_v, W['a_norm_g'][l], W['a_ws'][l], W['a_bs'][l])
    y_b, conv_state = _conv_module(b_a, b_g, conv_hist, W['b_dw_w'][l], W['b_dw_b'][l],
                                   W['b_ln_g'][l], W['b_ln_b'][l])
    pos = start + jnp.arange(t)
    q = (_rmsnorm(c_q, W['c_qa_g'][l]) @ W['c_w_uq'][l]).reshape(b, t, C_HEADS, C_NOPE + C_ROPE)
    q_nope = _rmsnorm(q[..., :C_NOPE], W['c_qn_g'][l])
    q_rope = _rope(_rmsnorm(q[..., C_NOPE:], W['c_qr_g'][l]), pos)
    lat_new = _rmsnorm(c_kv, W['c_kva_g'][l])
    kr_new = _rope(_rmsnorm(c_kr, W['c_kr_g'][l]), pos)
    if lat_past is None:
        lat_all, kr_all, kpos = lat_new, kr_new, pos
    else:
        lat_all = jnp.concatenate([lat_past.astype(lat_new.dtype), lat_new], axis=1)
        kr_all = jnp.concatenate([kr_past.astype(kr_new.dtype), kr_new], axis=1)
        kpos = jnp.arange(lat_past.shape[1] + t)
    kv = (lat_all @ W['c_w_ukv'][l]).reshape(b, lat_all.shape[1], C_HEADS, C_NOPE + C_VDIM)
    k_nope = _rmsnorm(kv[..., :C_NOPE], W['c_kn_g'][l])
    v = kv[..., C_NOPE:]
    if t > Q_BLOCK and t % Q_BLOCK == 0:
        nb = t // Q_BLOCK
        qn_b = q_nope.reshape(b, nb, Q_BLOCK, C_HEADS, C_NOPE).transpose(1, 0, 2, 3, 4)
        qr_b = q_rope.reshape(b, nb, Q_BLOCK, C_HEADS, C_ROPE).transpose(1, 0, 2, 3, 4)
        qp_b = pos.reshape(nb, Q_BLOCK)
        y_c = lax.map(lambda xs: _mla_attend(xs[0], xs[1], xs[2], k_nope, kr_all, v, kpos), (qn_b, qr_b, qp_b))
        y_c = y_c.transpose(1, 0, 2, 3).reshape(b, t, C_WIDTH)
    else:
        y_c = _mla_attend(q_nope, q_rope, pos, k_nope, kr_all, v, kpos)
    x = x + jnp.concatenate([y_a, y_b, y_c], axis=-1) @ W['w_out'][l]
    qm = _rmsnorm((_rmsnorm(x, W['norm_mem_g'][l]) @ W['w_mq'][l]).reshape(b, t, MEM_HEADS, MEM_HDIM),
                  W['m_q_g'][l])
    sm = jnp.einsum('bqhd,bkhd->bhqk', qm, mem_k.astype(qm.dtype)).astype(jnp.float32) * (1.0 / math.sqrt(MEM_HDIM))
    pm = jax.nn.softmax(sm, axis=-1).astype(x.dtype)
    om = jnp.einsum('bhqk,bkhd->bqhd', pm, mem_v.astype(x.dtype)).reshape(b, t, MEM_WIDTH)
    x = x + om @ W['w_mo'][l]
    x = x + jnp.square(jax.nn.relu(_rmsnorm(x, W['norm_ffn_g'][l]) @ W['w_ff1'][l])) @ W['w_ff2'][l]
    return x, v_rows, conv_state, lat_new, kr_new


def setup_inputs(seed: int = 0) -> dict:
    key = jax.random.key(seed)
    ks = iter(jax.random.split(key, 64))

    def nrm(shape, scale=1.0):
        return scale * jax.random.normal(next(ks), shape, jnp.float32)

    def gain(shape):
        return 1.0 + nrm(shape, 0.02)

    return {
        'x_prompt': nrm((BATCH, SEQ, D_MODEL)),
        'x_sample': nrm((DEC_BATCH, DEC_SEQ, D_MODEL)),
        'mem_prompt': nrm((BATCH, MEM_LEN, D_MODEL)),
        'cache_mla_latent': nrm((DEPTH, DEC_BATCH, PAST_LEN, C_KVRANK)),
        'cache_mla_krope': nrm((DEPTH, DEC_BATCH, PAST_LEN, C_ROPE)),
        'cache_conv': nrm((DEPTH, DEC_BATCH, B_KW - 1, B_WIDTH), 0.5),
        'cache_mem_k': nrm((DEPTH, DEC_BATCH, MEM_LEN, MEM_HEADS, MEM_HDIM)),
        'cache_mem_v': nrm((DEPTH, DEC_BATCH, MEM_LEN, MEM_HEADS, MEM_HDIM)),
        'norm_mix_g': gain((DEPTH, D_MODEL)),
        'w_in': nrm((DEPTH, D_MODEL, IN_WIDTH), D_MODEL ** -0.5),
        'a_norm_g': gain((DEPTH, A_WIDTH)),
        'a_ws': nrm((DEPTH, A_GROUPS, A_CHUNK, A_CHUNK), A_CHUNK ** -0.5),
        'a_bs': gain((DEPTH, A_GROUPS, A_CHUNK)),
        'b_dw_w': nrm((DEPTH, B_KW, B_WIDTH), B_KW ** -0.5),
        'b_dw_b': nrm((DEPTH, B_WIDTH), 0.02),
        'b_ln_g': gain((DEPTH, B_WIDTH)),
        'b_ln_b': nrm((DEPTH, B_WIDTH), 0.02),
        'c_qa_g': gain((DEPTH, C_QRANK)),
        'c_w_uq': nrm((DEPTH, C_QRANK, C_HEADS * (C_NOPE + C_ROPE)), C_QRANK ** -0.5),
        'c_kva_g': gain((DEPTH, C_KVRANK)),
        'c_w_ukv': nrm((DEPTH, C_KVRANK, C_HEADS * (C_NOPE + C_VDIM)), C_KVRANK ** -0.5),
        'c_qn_g': gain((DEPTH, C_NOPE)),
        'c_qr_g': gain((DEPTH, C_ROPE)),
        'c_kn_g': gain((DEPTH, C_NOPE)),
        'c_kr_g': gain((DEPTH, C_ROPE)),
        'w_out': nrm((DEPTH, MIX_WIDTH, D_MODEL), MIX_WIDTH ** -0.5),
        'norm_mem_g': gain((DEPTH, D_MODEL)),
        'mem_norm_g': gain((DEPTH, D_MODEL)),
        'w_mq': nrm((DEPTH, D_MODEL, MEM_WIDTH), D_MODEL ** -0.5),
        'w_mk': nrm((DEPTH, D_MODEL, MEM_WIDTH), D_MODEL ** -0.5),
        'w_mv': nrm((DEPTH, D_MODEL, MEM_WIDTH), D_MODEL ** -0.5),
        'w_mo': nrm((DEPTH, MEM_WIDTH, D_MODEL), MEM_WIDTH ** -0.5),
        'm_q_g': gain((DEPTH, MEM_HDIM)),
        'm_k_g': gain((DEPTH, MEM_HDIM)),
        'norm_ffn_g': gain((DEPTH, D_MODEL)),
        'w_ff1': nrm((DEPTH, D_MODEL, D_FF), D_MODEL ** -0.5),
        'w_ff2': nrm((DEPTH, D_FF, D_MODEL), D_FF ** -0.5),
    }


def reference(x_prompt, x_sample, mem_prompt, cache_mla_latent, cache_mla_krope, cache_conv,
              cache_mem_k, cache_mem_v, norm_mix_g, w_in, a_norm_g, a_ws, a_bs, b_dw_w, b_dw_b,
              b_ln_g, b_ln_b, c_qa_g, c_w_uq, c_kva_g, c_w_ukv, c_qn_g, c_qr_g, c_kn_g, c_kr_g,
              w_out, norm_mem_g, mem_norm_g, w_mq, w_mk, w_mv, w_mo, m_q_g, m_k_g, norm_ffn_g,
              w_ff1, w_ff2):
    W = dict(norm_mix_g=norm_mix_g, w_in=w_in, a_norm_g=a_norm_g, a_ws=a_ws, a_bs=a_bs,
             b_dw_w=b_dw_w, b_dw_b=b_dw_b, b_ln_g=b_ln_g, b_ln_b=b_ln_b, c_qa_g=c_qa_g,
             c_w_uq=c_w_uq, c_kva_g=c_kva_g, c_w_ukv=c_w_ukv, c_qn_g=c_qn_g, c_qr_g=c_qr_g,
             c_kn_g=c_kn_g, c_kr_g=c_kr_g, w_out=w_out, norm_mem_g=norm_mem_g,
             mem_norm_g=mem_norm_g, w_mq=w_mq, w_mk=w_mk, w_mv=w_mv, w_mo=w_mo, m_q_g=m_q_g,
             m_k_g=m_k_g, norm_ffn_g=norm_ffn_g, w_ff1=w_ff1, w_ff2=w_ff2)
    past = cache_mla_latent.shape[2]
    hp, hs = x_prompt, x_sample
    lat_p, kr_p, conv_p, mk_p, mv_p = [], [], [], [], []
    lat_s, kr_s, conv_s, gv_s = [], [], [], []
    for l in range(DEPTH):
        mk, mv = _mem_kv(mem_prompt, l, W)
        hp, _, cst, lat, kr = _layer(hp, l, W, mk, mv, None, None, None, 0)
        lat_p.append(lat); kr_p.append(kr); conv_p.append(cst); mk_p.append(mk); mv_p.append(mv)
        hs, gv, cst, lat, kr = _layer(hs, l, W, cache_mem_k[l], cache_mem_v[l], cache_conv[l],
                                      cache_mla_latent[l], cache_mla_krope[l], past)
        lat_s.append(lat); kr_s.append(kr); conv_s.append(cst); gv_s.append(gv)
    return (hp, hs,
            jnp.stack(lat_p), jnp.stack(kr_p), jnp.stack(conv_p), jnp.stack(mk_p), jnp.stack(mv_p),
            jnp.stack(lat_s), jnp.stack(kr_s), jnp.stack(conv_s), jnp.stack(gv_s))
```

```cpp
#include <hip/hip_runtime.h>
#include <hip/hip_cooperative_groups.h>
#include <cstdio>
#include <cstdint>
namespace cg = cooperative_groups;
namespace pg8 {
#define PG8_LAS __attribute__((address_space(3)))
typedef unsigned short bf16_t;
typedef short bf16x8 __attribute__((ext_vector_type(8)));
typedef float f32x4 __attribute__((ext_vector_type(4)));
typedef unsigned u32x4 __attribute__((ext_vector_type(4)));
constexpr int BM = 256, BK = 64, HALF = 128, HTB = HALF * BK * 2  , STAGE_BYTES = 8 * HTB, NXCD = 8, WGM = 8;

__host__ __device__ __forceinline__ int lds_byte(int r, int c) { const int st = (r >> 4) * 2 + (c >> 5), rr = r & 15, cc = c & 31, ob = rr * 64 + cc * 2; return st * 1024 + (ob ^ (((ob >> 9) & 1) << 5)); }
__host__ __device__ __forceinline__ void stage_rc(int b, int& R, int& C) { const int st = b / 1024, sb = b % 1024, swz = sb ^ (((sb >> 9) & 1) << 5); R = (st >> 1) * 16 + swz / 64; C = (st & 1) * 32 + (swz % 64) / 2; }
__host__ __device__ __forceinline__ int perm32(int rho) { const int n = rho >> 4, i = rho & 15; return 8 * (i >> 2) + 4 * n + (i & 3); }

struct Unit { int pm, pn; };
struct Gemm { const bf16_t* A; const bf16_t* Bt; int M, N, K; };

struct StaticOrder {
    int nM, nN, nwg, G, c;
    __host__ __device__ void init(int M, int N, int G_, int c_) { nM = M / BM; nN = N / BM; nwg = nM * nN; G = G_; c = c_; }
    __host__ __device__ bool next(int i, Unit& u) const {
        const long L = (long)i * G + c; if (L >= nwg) return false;
        int wgid = (int)L; { const int q = nwg / NXCD, r = nwg % NXCD, xcd = wgid % NXCD, off = wgid / NXCD; wgid = (xcd < r ? xcd * (q + 1) : r * (q + 1) + (xcd - r) * q) + off; }
        const int nig = WGM * nN, gid = wgid / nig, fm = gid * WGM, gsz = (nM - fm) < WGM ? (nM - fm) : WGM;
        u.pm = fm + ((wgid % nig) % gsz); u.pn = (wgid % nig) / gsz; return true;
    }
    __device__ __forceinline__ void a_ready(const Unit&) const {}
    __device__ __forceinline__ void done(const Unit&) const {}
};

__device__ __forceinline__ unsigned cvt_pk_bf16(float lo, float hi) { unsigned r; asm volatile("v_cvt_pk_bf16_f32 %0, %1, %2" : "=v"(r) : "v"(lo), "v"(hi)); return r; }
typedef float f32x2 __attribute__((ext_vector_type(2)));
__device__ __forceinline__ f32x2 gelu_pk(f32x2 v) {
    const f32x2 av = __builtin_elementwise_abs(v), d = av * 0.2316418882f + 1.0f;
    f32x2 t; t.x = __builtin_amdgcn_rcpf(d.x); t.y = __builtin_amdgcn_rcpf(d.y);
    f32x2 q = t * 0.5307027145f + (-0.7265760135f); q = q * t + 0.7107068705f; q = q * t + (-0.142248368f); q = q * t + 0.127414796f; q = q * t;
    const f32x2 s = (v * v) * (-0.72134752044f);
    f32x2 e; e.x = __builtin_amdgcn_exp2f(s.x); e.y = __builtin_amdgcn_exp2f(s.y);
    const f32x2 m = v * (q * e), r = v - m;
    f32x2 o; o.x = v.x < 0.f ? m.x : r.x; o.y = v.y < 0.f ? m.y : r.y; return o;
}

template <class Epi, class Sched, bool ALIGN_EPI = false, bool SP2 = false>
__device__ __forceinline__ void gemm_phase(PG8_LAS unsigned char* lds, const Gemm g, const Sched& S, const Epi& E) {
    int tid = threadIdx.x; asm volatile("" : "+v"(tid));
    const int wid = __builtin_amdgcn_readfirstlane(tid >> 6), lane = tid & 63, wr = wid >> 2, wc = wid & 3, fr = lane & 15, fq = lane >> 4;
    const int K = g.K, nt = K / BK;
    unsigned voffA[2], voffB[2];
#pragma unroll
    for (int i = 0; i < 2; ++i) { int R, C; stage_rc(tid * 16 + i * 8192, R, C); const int Rb = Epi::PERM ? ((R & ~31) + perm32(R & 31)) : R;
        voffA[i] = (unsigned)(R * K + C) * 2u; voffB[i] = (unsigned)(Rb * K + C) * 2u; }
    const size_t kstep = (size_t)(BK * 2);
    const size_t hstep = (size_t)HALF * K * 2;
    const size_t tstep = 2 * hstep;
    const unsigned ldsw = (unsigned)wid * 1024u;
    const int aoff = lds_byte(wr * 64 + fr, fq * 8), boff = lds_byte(wc * 32 + fr, fq * 8);
#define PG8_SA(b, h) (((b) * 2 + (h)) * HTB)
#define PG8_SB(b, h) ((4 + (b) * 2 + (h)) * HTB)
#define PG8_STAGE(bufoff, gbase, voff) do { _Pragma("unroll") for (int _i = 0; _i < 2; ++_i) \
        __builtin_amdgcn_global_load_lds((const unsigned*)((const char*)(gbase) + (voff)[_i]), (PG8_LAS unsigned*)(lds + (bufoff) + ldsw + _i * 8192), 16, 0, 0); } while (0)
#define PG8_LDA(dst, b, h) do { _Pragma("unroll") for (int m = 0; m < 4; ++m) _Pragma("unroll") for (int k = 0; k < 2; ++k) dst[m][k] = *(const PG8_LAS bf16x8*)(lds + PG8_SA(b, h) + aoff + m * 2048 + k * 1024); } while (0)
#define PG8_LDB(dst, b, h) do { _Pragma("unroll") for (int n = 0; n < 2; ++n) _Pragma("unroll") for (int k = 0; k < 2; ++k) dst[n][k] = *(const PG8_LAS bf16x8*)(lds + PG8_SB(b, h) + boff + n * 2048 + k * 1024); } while (0)
#define PG8_MMA(ai, bj, At, Bt) do { __builtin_amdgcn_s_setprio(1); _Pragma("unroll") for (int m = 0; m < 4; ++m) _Pragma("unroll") for (int n = 0; n < 2; ++n) _Pragma("unroll") for (int k = 0; k < 2; ++k) \
        acc[ai][bj][m][n] = __builtin_amdgcn_mfma_f32_16x16x32_bf16(Bt[n][k], At[m][k], acc[ai][bj][m][n], 0, 0, 0); __builtin_amdgcn_s_setprio(0); } while (0)
#define PG8_WAIT_V(n) asm volatile("s_waitcnt vmcnt(" #n ")" ::: "memory")
#define PG8_WAIT_L(n) asm volatile("s_waitcnt lgkmcnt(" #n ")" ::: "memory")
#define PG8_BAR __builtin_amdgcn_s_barrier()
#define PG8_SCHED __builtin_amdgcn_sched_barrier(0)
    Unit cur, nxt; int ui = 0;
    if (!S.next(0, cur)) return;
    f32x4 acc[2][2][4][2];
#pragma unroll
    for (int a = 0; a < 2; ++a)
#pragma unroll
        for (int b = 0; b < 2; ++b)
#pragma unroll
            for (int m = 0; m < 4; ++m)
#pragma unroll
                for (int n = 0; n < 2; ++n) acc[a][b][m][n] = (f32x4){0.f, 0.f, 0.f, 0.f};
    bf16x8 At[4][2], B0[2][2], B1[2][2];
    const char* cA = (const char*)g.A + (size_t)cur.pm * tstep; const char* cB = (const char*)g.Bt + (size_t)cur.pn * tstep;
    S.a_ready(cur);
    if constexpr (SP2) {
        PG8_STAGE(PG8_SB(0, 0), cB, voffB); PG8_STAGE(PG8_SB(0, 1), cB + hstep, voffB); PG8_STAGE(PG8_SA(0, 0), cA, voffA); PG8_STAGE(PG8_SA(0, 1), cA + hstep, voffA);
        if (wr == 1) PG8_BAR;
        PG8_WAIT_V(2); PG8_BAR;
        PG8_STAGE(PG8_SB(1, 0), cB + kstep, voffB); PG8_STAGE(PG8_SA(1, 0), cA + kstep, voffA); PG8_STAGE(PG8_SB(1, 1), cB + hstep + kstep, voffB);
        PG8_WAIT_V(6); PG8_BAR;
    } else {
        PG8_STAGE(PG8_SB(0, 0), cB, voffB); PG8_STAGE(PG8_SA(0, 0), cA, voffA); PG8_STAGE(PG8_SB(0, 1), cB + hstep, voffB); PG8_STAGE(PG8_SA(0, 1), cA + hstep, voffA);
        if (wr == 1) PG8_BAR;
        PG8_WAIT_V(4); PG8_BAR;
        PG8_STAGE(PG8_SB(1, 0), cB + kstep, voffB); PG8_STAGE(PG8_SA(1, 0), cA + kstep, voffA); PG8_STAGE(PG8_SB(1, 1), cB + hstep + kstep, voffB);
        PG8_WAIT_V(6); PG8_BAR;
    }
    for (;;) {
        const bool has_next = S.next(ui + 1, nxt);
        const char* nA = has_next ? (const char*)g.A + (size_t)nxt.pm * tstep : cA; const char* nB = has_next ? (const char*)g.Bt + (size_t)nxt.pn * tstep : cB;
        for (int t = 0; t < nt; t += 2) {
            const bool last = (t == nt - 2);
            const char* a1 = cA + (size_t)(t + 1) * kstep;
            const char* a2 = last ? nA : cA + (size_t)(t + 2) * kstep; const char* b2 = last ? nB : cB + (size_t)(t + 2) * kstep;
            const char* a3 = a2 + kstep; const char* b3 = b2 + kstep;
            if (last && has_next) S.a_ready(nxt);
            if constexpr (SP2) {
            PG8_LDB(B0, 0, 0); PG8_LDB(B1, 0, 1); PG8_SCHED; PG8_LDA(At, 0, 0); PG8_STAGE(PG8_SA(1, 1), a1 + hstep, voffA);
            PG8_WAIT_V(8); PG8_WAIT_L(0); PG8_BAR; PG8_MMA(0, 0, At, B0); PG8_MMA(0, 1, At, B1); PG8_BAR; PG8_SCHED;
            PG8_LDA(At, 0, 1); PG8_STAGE(PG8_SB(0, 0), b2, voffB); PG8_STAGE(PG8_SB(0, 1), b2 + hstep, voffB); PG8_STAGE(PG8_SA(0, 0), a2, voffA);
            PG8_WAIT_V(8); PG8_WAIT_L(0); PG8_BAR; PG8_MMA(1, 0, At, B0); PG8_MMA(1, 1, At, B1); PG8_BAR; PG8_SCHED;
            PG8_LDB(B0, 1, 0); PG8_LDB(B1, 1, 1); PG8_SCHED; PG8_LDA(At, 1, 0); PG8_STAGE(PG8_SA(0, 1), a2 + hstep, voffA);
            PG8_WAIT_V(8); PG8_WAIT_L(0); PG8_BAR; PG8_MMA(0, 0, At, B0); PG8_MMA(0, 1, At, B1); PG8_BAR; PG8_SCHED;
            PG8_LDA(At, 1, 1); PG8_STAGE(PG8_SB(1, 0), b3, voffB); PG8_STAGE(PG8_SB(1, 1), b3 + hstep, voffB); PG8_STAGE(PG8_SA(1, 0), a3, voffA);
            PG8_WAIT_V(8); PG8_WAIT_L(0); PG8_BAR; PG8_MMA(1, 0, At, B0); PG8_MMA(1, 1, At, B1); PG8_BAR; PG8_SCHED;
            } else {
            PG8_LDB(B0, 0, 0); PG8_SCHED; PG8_LDA(At, 0, 0); PG8_STAGE(PG8_SA(1, 1), a1 + hstep, voffA);
            PG8_WAIT_L(8); PG8_BAR; PG8_WAIT_L(0); PG8_MMA(0, 0, At, B0); PG8_BAR; PG8_SCHED;
            PG8_LDB(B1, 0, 1); PG8_STAGE(PG8_SB(0, 0), b2, voffB);
            PG8_BAR; PG8_WAIT_L(0); PG8_MMA(0, 1, At, B1); PG8_BAR;
            PG8_LDA(At, 0, 1); PG8_STAGE(PG8_SA(0, 0), a2, voffA);
            PG8_BAR; PG8_WAIT_L(0); PG8_MMA(1, 0, At, B0); PG8_BAR; PG8_SCHED;
            PG8_STAGE(PG8_SB(0, 1), b2 + hstep, voffB);
            PG8_WAIT_V(6); PG8_BAR; PG8_MMA(1, 1, At, B1); PG8_BAR;
            PG8_LDB(B0, 1, 0); PG8_SCHED; PG8_LDA(At, 1, 0); PG8_STAGE(PG8_SA(0, 1), a2 + hstep, voffA);
            PG8_WAIT_L(8); PG8_BAR; PG8_WAIT_L(0); PG8_MMA(0, 0, At, B0); PG8_BAR; PG8_SCHED;
            PG8_LDB(B1, 1, 1); PG8_STAGE(PG8_SB(1, 0), b3, voffB);
            PG8_BAR; PG8_WAIT_L(0); PG8_MMA(0, 1, At, B1); PG8_BAR;
            PG8_LDA(At, 1, 1); PG8_STAGE(PG8_SA(1, 0), a3, voffA);
            PG8_BAR; PG8_WAIT_L(0); PG8_MMA(1, 0, At, B0); PG8_BAR; PG8_SCHED;
            PG8_STAGE(PG8_SB(1, 1), b3 + hstep, voffB);
            PG8_WAIT_V(6); PG8_BAR; PG8_MMA(1, 1, At, B1); PG8_BAR;
            }
        }
        if constexpr (ALIGN_EPI) { if (wr == 0) PG8_BAR; }
        if constexpr (!Epi::AFTER_DRAIN) { E(acc, cur, wr, wc, fr, fq); S.done(cur); }
        if (!has_next) break;
#pragma unroll
        for (int a = 0; a < 2; ++a)
#pragma unroll
            for (int b = 0; b < 2; ++b)
#pragma unroll
                for (int m = 0; m < 4; ++m)
#pragma unroll
                    for (int n = 0; n < 2; ++n) acc[a][b][m][n] = (f32x4){0.f, 0.f, 0.f, 0.f};
        cur = nxt; cA = nA; cB = nB; ++ui;
        if constexpr (ALIGN_EPI) { if (wr == 1) PG8_BAR; }
    }
    PG8_WAIT_V(0);
    if constexpr (!ALIGN_EPI) { if (wr == 0) PG8_BAR; }
    PG8_BAR;
    if constexpr (Epi::AFTER_DRAIN) { E.fused(acc, cur, wr, wc, fr, fq, lds, wid, lane); S.done(cur); }
#undef PG8_SA
#undef PG8_SB
#undef PG8_STAGE
#undef PG8_LDA
#undef PG8_LDB
#undef PG8_MMA
#undef PG8_WAIT_V
#undef PG8_WAIT_L
#undef PG8_BAR
#undef PG8_SCHED
}
}

#define LAS __attribute__((address_space(3)))
typedef unsigned short bf16;
typedef unsigned u32x4 __attribute__((ext_vector_type(4)));
typedef unsigned u32x2 __attribute__((ext_vector_type(2)));
typedef float f32x4 __attribute__((ext_vector_type(4)));
typedef float f32x16 __attribute__((ext_vector_type(16)));
typedef short bf16x8 __attribute__((ext_vector_type(8)));

constexpr int TP = 32768, TV = 32896, TT = 33024;
constexpr int LR = 41216, LRV = 41088;
constexpr int SKV = 1040, KHS_T = 1104;
constexpr float EPS = 1e-6f;
constexpr float LOG2E = 1.4426950408889634f;
constexpr float SC_MLA = 0.10206207261596577f * LOG2E;
constexpr float SC_MEM = 0.08838834764831845f * LOG2E;

constexpr size_t al256(size_t x) { return (x + 255) & ~(size_t)255; }
constexpr size_t OFF_CTL = 0, CTL_BYTES = 16384;
constexpr size_t OFF_SS = CTL_BYTES;
constexpr size_t OFF_MSS = al256(OFF_SS + (size_t)6 * TT * 4);
constexpr size_t OFF_ROPE = al256(OFF_MSS + 1024 * 4);
constexpr size_t W_WIN = 0, W_WUQ = W_WIN + (size_t)1536 * 1024 * 2, W_WK = W_WUQ + (size_t)768 * 256 * 2, W_WVT = W_WK + (size_t)512 * 128 * 2,
                 W_WOUT = W_WVT + (size_t)512 * 128 * 2, W_WMQ = W_WOUT + (size_t)1024 * 1024 * 2, W_WMO = W_WMQ + (size_t)512 * 1024 * 2,
                 W_FF1 = W_WMO + (size_t)1024 * 512 * 2, W_FF2 = W_FF1 + (size_t)4096 * 1024 * 2, W_LAYER = W_FF2 + (size_t)1024 * 4096 * 2;
constexpr size_t OFF_W = al256(OFF_ROPE + (size_t)8192 * 16 * 8);
constexpr size_t OFF_WMKV = OFF_W + 2 * W_LAYER;
constexpr size_t OFF_MEMB = OFF_WMKV + (size_t)2048 * 1024 * 2;
constexpr size_t OFF_MKVRAW = OFF_MEMB + (size_t)1024 * 1024 * 2;
constexpr size_t OFF_MK = OFF_MKVRAW + (size_t)1024 * 2048 * 4;
constexpr size_t OFF_MVT = OFF_MK + (size_t)2 * 12 * 4 * 256 * 128 * 2;
constexpr size_t OFF_XB = OFF_MVT + (size_t)2 * 12 * 4 * 256 * 128 * 2;
constexpr size_t OFF_LATC = OFF_XB + (size_t)TT * 1024 * 2;
constexpr size_t OFF_KR = OFF_LATC + (size_t)LR * 128 * 2;
constexpr size_t OFF_UG = OFF_KR + (size_t)LR * 32 * 2;
constexpr size_t OFF_VG = OFF_UG + (size_t)TT * 256 * 2, OFF_Z = OFF_VG + (size_t)TT * 256 * 2, OFF_CQ = OFF_Z + (size_t)TT * 256 * 2;
constexpr size_t OFF_A = OFF_CQ + (size_t)TT * 256 * 2;
constexpr size_t SZ_A = (size_t)TT * 1536 * 2;
constexpr size_t OFF_H = OFF_A, OFF_QRAW = OFF_A, OFF_KRAW = OFF_A + (size_t)TT * 768 * 2, OFF_QMRAW = OFF_A, OFF_OM = OFF_A + (size_t)TT * 512 * 2;
static_assert((size_t)TT * 768 * 2 + (size_t)LR * 512 * 2 <= SZ_A, "region A");
constexpr size_t OFF_B = OFF_A + SZ_A;
constexpr size_t OFF_VT = OFF_B, OFF_KH = OFF_VT + (size_t)512 * LR * 2, OFF_KHS = OFF_KH + (size_t)32 * 8192 * 96 * 2;
constexpr size_t OFF_C = OFF_KHS + (size_t)64 * KHS_T * 96 * 2;
constexpr size_t OFF_MIX = OFF_C;
constexpr size_t OFF_HID = OFF_A;
constexpr size_t WS_END = OFF_MIX + (size_t)TT * 1024 * 2;
static_assert(OFF_HID + (size_t)TT * 4096 * 2 <= WS_END, "HID overlay");

constexpr size_t O_YP = 0, O_YS = 33554432, O_LATP = 33685504, O_KRP = 42074112, O_CONVP = 44171264, O_MKP = 44232704, O_MVP = 45281280,
                 O_LATS = 46329856, O_KRS = 46362624, O_CONVS = 46370816, O_GVS = 46493696, O_END = 46559232;

constexpr int LDS_BYTES = 147456;
constexpr int NPHASE = 23;

struct Params { const float* in[37]; float* out; unsigned char* ws; int ph_lo, ph_hi; };

__device__ __forceinline__ float bflo(unsigned w) { return __uint_as_float(w << 16); }
__device__ __forceinline__ float bfhi(unsigned w) { return __uint_as_float(w & 0xffff0000u); }
__device__ __forceinline__ unsigned pk2(float lo, float hi) {
    typedef float f2_t __attribute__((ext_vector_type(2))); typedef __bf16 b2_t __attribute__((ext_vector_type(2)));
    f2_t v = {lo, hi}; b2_t b = __builtin_convertvector(v, b2_t); return __builtin_bit_cast(unsigned, b);
}
template <int CTRL> __device__ __forceinline__ float dpp_add(float v) {
    return v + __builtin_bit_cast(float, __builtin_amdgcn_update_dpp(0, __builtin_bit_cast(int, v), CTRL, 0xf, 0xf, true));
}
__device__ __forceinline__ float sum4(float v) { v = dpp_add<0xB1>(v); return dpp_add<0x4E>(v); }
__device__ __forceinline__ float sum8(float v) { return dpp_add<0x141>(sum4(v)); }
__device__ __forceinline__ float sum16(float v) { return dpp_add<0x140>(sum8(v)); }
__device__ __forceinline__ float swap16_sum(float v) {
    auto rr = __builtin_amdgcn_permlane16_swap(__float_as_uint(v), __float_as_uint(v), false, false);
    return __uint_as_float(rr[0]) + __uint_as_float(rr[1]);
}
__device__ __forceinline__ float half_sum(float v);
__device__ __forceinline__ float wave_sum(float v) { return half_sum(swap16_sum(sum16(v))); }
__device__ __forceinline__ float half_sum(float v) {
    auto rr = __builtin_amdgcn_permlane32_swap(__float_as_uint(v), __float_as_uint(v), false, false);
    return __uint_as_float(rr[0]) + __uint_as_float(rr[1]);
}
__device__ __forceinline__ float half_max(float v) {
    auto rr = __builtin_amdgcn_permlane32_swap(__float_as_uint(v), __float_as_uint(v), false, false);
    return fmaxf(__uint_as_float(rr[0]), __uint_as_float(rr[1]));
}
__device__ __forceinline__ float gelu_f(float x) { return 0.5f * x * (1.0f + erff(x * 0.70710678118654752f)); }
__device__ __forceinline__ float sigm_f(float x) { return 1.0f / (1.0f + __expf(-x)); }

struct EpiU {
    static constexpr bool PERM = false, AFTER_DRAIN = false;
    int mode;
    int relu2;
    void* out; int ldc;
    const float* ss; float ssdiv;
    float* ssout;
    const float* base_p; const float* base_s; bf16* xb;
    const float* gkn; const bf16* kr; bf16* kh; bf16* khs;
    __device__ __forceinline__ void operator()(const pg8::f32x4 (&acc)[2][2][4][2], const pg8::Unit& u, int wr, int wc, int fr, int fq) const {
        const int row0 = u.pm * 256 + wr * 64 + fr, col0 = u.pn * 256 + wc * 32 + 4 * fq;
#pragma unroll
        for (int ai = 0; ai < 2; ++ai)
#pragma unroll
            for (int m = 0; m < 4; ++m) {
                const int row = row0 + ai * 128 + m * 16;
                const float rs = ss ? rsqrtf(ss[row] * ssdiv + EPS) : 1.0f;
#pragma unroll
                for (int bj = 0; bj < 2; ++bj)
#pragma unroll
                    for (int n = 0; n < 2; ++n) { const int c = col0 + bj * 128 + n * 16; *(f32x4*)((float*)out + (size_t)row * ldc + c) = acc[ai][bj][m][n] * rs; }
            }
    }
};

struct EpiP {
    static constexpr bool PERM = true, AFTER_DRAIN = false;
    int mode;
    int relu2; void* out; int ldc; const float* ss; float ssdiv; float* ssout; bf16* xb;
    const float* gkn; const bf16* kr; bf16* kh; bf16* khs;
    __device__ __forceinline__ void operator()(const pg8::f32x4 (&acc)[2][2][4][2], const pg8::Unit& u, int wr, int wc, int fr, int fq) const {
        const int row0 = u.pm * 256 + wr * 64 + fr, col0 = u.pn * 256 + wc * 32 + 8 * fq;
        if (mode == 0) {
            float rsv[2][4];
#pragma unroll
            for (int ai = 0; ai < 2; ++ai)
#pragma unroll
                for (int m = 0; m < 4; ++m) rsv[ai][m] = ss ? ss[row0 + ai * 128 + m * 16] : 0.f;
#pragma unroll
            for (int ai = 0; ai < 2; ++ai)
#pragma unroll
                for (int m = 0; m < 4; ++m) {
                    const int row = row0 + ai * 128 + m * 16;
                    const float rs = ss ? rsqrtf(rsv[ai][m] * ssdiv + EPS) : 1.0f;
                    bf16* rowp = (bf16*)out + (size_t)row * ldc + col0;
#pragma unroll
                    for (int bj = 0; bj < 2; ++bj) { f32x4 v0 = acc[ai][bj][m][0] * rs, v1 = acc[ai][bj][m][1] * rs;
                        if (relu2) { v0[0] = fmaxf(v0[0], 0.f); v0[1] = fmaxf(v0[1], 0.f); v0[2] = fmaxf(v0[2], 0.f); v0[3] = fmaxf(v0[3], 0.f); v0 = v0 * v0;
                                     v1[0] = fmaxf(v1[0], 0.f); v1[1] = fmaxf(v1[1], 0.f); v1[2] = fmaxf(v1[2], 0.f); v1[3] = fmaxf(v1[3], 0.f); v1 = v1 * v1; }
                        u32x4 w; w.x = pk2(v0[0], v0[1]); w.y = pk2(v0[2], v0[3]); w.z = pk2(v1[0], v1[1]); w.w = pk2(v1[2], v1[3]);
                        *(u32x4*)(rowp + bj * 128) = w; }
                }
        } else if (mode == 1) {
#pragma unroll
            for (int ai = 0; ai < 2; ++ai) {
                u32x4 bwv[4][2];
#pragma unroll
                for (int m = 0; m < 4; ++m)
#pragma unroll
                    for (int bj = 0; bj < 2; ++bj) bwv[m][bj] = *(const u32x4*)(xb + (size_t)(row0 + ai * 128 + m * 16) * 1024 + col0 + bj * 128);
#pragma unroll
                for (int m = 0; m < 4; ++m) {
                    const int row = row0 + ai * 128 + m * 16; float s2 = 0.f;
                    bf16* xp = xb + (size_t)row * 1024 + col0; float* op = (float*)out + (size_t)row * 1024 + col0;
#pragma unroll
                    for (int bj = 0; bj < 2; ++bj) { const u32x4 bw = bwv[m][bj];
                        const f32x4 x0 = (f32x4){bflo(bw.x), bfhi(bw.x), bflo(bw.y), bfhi(bw.y)} + acc[ai][bj][m][0], x1 = (f32x4){bflo(bw.z), bfhi(bw.z), bflo(bw.w), bfhi(bw.w)} + acc[ai][bj][m][1];
                        if (out) { *(f32x4*)(op + bj * 128) = x0; *(f32x4*)(op + bj * 128 + 4) = x1; }
                        else { u32x4 w; w.x = pk2(x0[0], x0[1]); w.y = pk2(x0[2], x0[3]); w.z = pk2(x1[0], x1[1]); w.w = pk2(x1[2], x1[3]); *(u32x4*)(xp + bj * 128) = w; }
                        s2 += ((x0[0] * x0[0] + x0[1] * x0[1]) + (x0[2] * x0[2] + x0[3] * x0[3])) + ((x1[0] * x1[0] + x1[1] * x1[1]) + (x1[2] * x1[2] + x1[3] * x1[3])); }
                    s2 = half_sum(swap16_sum(s2));
                    if (fq == 0) unsafeAtomicAdd(ssout + row, s2);
                }
            }
        } else {
            const int hh = 4 * u.pn + wc;
            f32x4 gv[2][2];
#pragma unroll
            for (int bj = 0; bj < 2; ++bj)
#pragma unroll
                for (int n = 0; n < 2; ++n) gv[bj][n] = *(const f32x4*)(gkn + 32 * bj + 8 * fq + 4 * n);
            u32x4 krv[2][4];
#pragma unroll
            for (int ai = 0; ai < 2; ++ai)
#pragma unroll
                for (int m = 0; m < 4; ++m) { const int r = row0 + ai * 128 + m * 16; krv[ai][m] = *(const u32x4*)(kr + (size_t)(r < LRV ? r : 0) * 32 + 8 * fq); }
#pragma unroll
            for (int ai = 0; ai < 2; ++ai)
#pragma unroll
                for (int m = 0; m < 4; ++m) {
                    const int r = row0 + ai * 128 + m * 16; float s2 = 0.f;
#pragma unroll
                    for (int bj = 0; bj < 2; ++bj)
#pragma unroll
                        for (int n = 0; n < 2; ++n) { const f32x4 x = acc[ai][bj][m][n]; s2 += (x[0] * x[0] + x[1] * x[1]) + (x[2] * x[2] + x[3] * x[3]); }
                    s2 = half_sum(swap16_sum(s2));
                    const float rs = rsqrtf(s2 * (1.0f / 64.0f) + EPS);
                    if (r < LRV) {
                        bf16* dst;
                        if (r < TP) { const int b = r >> 13, t = r & 8191; dst = kh + ((size_t)(b * 8 + hh) * 8192 + t) * 96; }
                        else { const int rr = r - TP, b = rr / SKV, t = rr - b * SKV; dst = khs + ((size_t)(b * 8 + hh) * KHS_T + t) * 96; }
#pragma unroll
                        for (int bj = 0; bj < 2; ++bj) { const f32x4 v0 = acc[ai][bj][m][0] * rs * gv[bj][0], v1 = acc[ai][bj][m][1] * rs * gv[bj][1];
                            u32x4 w; w.x = pk2(v0[0], v0[1]); w.y = pk2(v0[2], v0[3]); w.z = pk2(v1[0], v1[1]); w.w = pk2(v1[2], v1[3]);
                            *(u32x4*)(dst + 32 * bj + 8 * fq) = w; }
                        *(u32x4*)(dst + 64 + 8 * fq) = krv[ai][m];
                    }
                }
        }
    }
};

#define MFMA32(a, b, c) __builtin_amdgcn_mfma_f32_32x32x16_bf16((a), (b), (c), 0, 0, 0)
template <int KSTR, int VSTR> struct SrcLds {
    const LAS char* k; const LAS char* v;
    __device__ __forceinline__ bf16x8 kfrag(int hf, int s) const { return *(const LAS bf16x8*)(k + hf * 32 * KSTR + s * 32); }
    __device__ __forceinline__ bf16x8 vfrag(int dd, int hf, int s2) const { return *(const LAS bf16x8*)(v + dd * 32 * VSTR + hf * 64 + s2 * 32); }
};
#define MX3(a, b, c) __builtin_fmaxf(__builtin_fmaxf((a), (b)), (c))
template <int NS, int ND, class Src>
__device__ __forceinline__ void attn_tile(const bf16x8 (&q)[NS], f32x16 (&o)[ND], bool& shifted, float& m, float& l, const Src& src, int kvalid, int hi) {
    f32x16 z;
#pragma unroll
    for (int r = 0; r < 16; ++r) z[r] = 0.f;
    f32x16 p0 = MFMA32(src.kfrag(0, 0), q[0], z), p1 = MFMA32(src.kfrag(1, 0), q[0], z);
#pragma unroll
    for (int s = 1; s < NS; ++s) { p0 = MFMA32(src.kfrag(0, s), q[s], p0); p1 = MFMA32(src.kfrag(1, s), q[s], p1); }
    if (kvalid < 64) {
#pragma unroll
        for (int r = 0; r < 16; ++r) { const int kv = 16 * (r >> 3) + 8 * hi + (r & 7); if (kv >= kvalid) p0[r] = -INFINITY; if (kv + 32 >= kvalid) p1[r] = -INFINITY; }
    }
    float ma = MX3(p0[0], p0[1], p1[0]), mb = MX3(p0[2], p0[3], p1[1]); ma = MX3(ma, p1[2], p1[3]);
#pragma unroll
    for (int r = 4; r < 16; r += 4) { ma = MX3(ma, p0[r], p0[r + 1]); mb = MX3(mb, p0[r + 2], p0[r + 3]); ma = MX3(ma, p1[r], p1[r + 1]); mb = MX3(mb, p1[r + 2], p1[r + 3]); }
    const float mx = half_max(fmaxf(ma, mb)) - m;
    if (__any(fabsf(mx) > 8.0f)) {
        const float dl = fabsf(mx) > 8.0f ? mx : 0.0f; m += dl;
        const float f = __builtin_amdgcn_exp2f(-dl); l *= f;
#pragma unroll
        for (int dd = 0; dd < ND; ++dd) o[dd] = o[dd] * f;
        shifted = __any(m != 0.0f);
    }
    if (shifted) {
#pragma unroll
        for (int r = 0; r < 16; ++r) { p0[r] -= m; p1[r] -= m; }
    }
    float sum = 0.f; bf16x8 pb0, pb1;
#pragma unroll
    for (int r = 0; r < 16; ++r) { p0[r] = __builtin_amdgcn_exp2f(p0[r]); sum += p0[r]; }
    { u32x4 w; w.x = pk2(p0[0], p0[1]); w.y = pk2(p0[2], p0[3]); w.z = pk2(p0[4], p0[5]); w.w = pk2(p0[6], p0[7]); pb0 = __builtin_bit_cast(bf16x8, w);
      w.x = pk2(p0[8], p0[9]); w.y = pk2(p0[10], p0[11]); w.z = pk2(p0[12], p0[13]); w.w = pk2(p0[14], p0[15]); pb1 = __builtin_bit_cast(bf16x8, w); }
#pragma unroll
    for (int dd = 0; dd < ND; ++dd) { o[dd] = MFMA32(src.vfrag(dd, 0, 0), pb0, o[dd]); o[dd] = MFMA32(src.vfrag(dd, 0, 1), pb1, o[dd]); }
#pragma unroll
    for (int r = 0; r < 16; ++r) { p1[r] = __builtin_amdgcn_exp2f(p1[r]); sum += p1[r]; }
    { u32x4 w; w.x = pk2(p1[0], p1[1]); w.y = pk2(p1[2], p1[3]); w.z = pk2(p1[4], p1[5]); w.w = pk2(p1[6], p1[7]); pb0 = __builtin_bit_cast(bf16x8, w);
      w.x = pk2(p1[8], p1[9]); w.y = pk2(p1[10], p1[11]); w.z = pk2(p1[12], p1[13]); w.w = pk2(p1[14], p1[15]); pb1 = __builtin_bit_cast(bf16x8, w); }
#pragma unroll
    for (int dd = 0; dd < ND; ++dd) { o[dd] = MFMA32(src.vfrag(dd, 1, 0), pb0, o[dd]); o[dd] = MFMA32(src.vfrag(dd, 1, 1), pb1, o[dd]); }
    l += sum;
}

template <int DQK, int DV>
__device__ __forceinline__ void attn_block(LAS char* lds, const bf16x8 (&q)[DQK / 16], const bf16* Kg, const bf16* Vg, int vstride, int ntile, int mynt, int kvlen,
                                           f32x16 (&o)[DV / 32], float& lsum) {
    constexpr int NS = DQK / 16, ND = DV / 32, KSTR = DQK * 2 + 16, VSTR = 144, KB = 64 * KSTR, VB = DV * VSTR, BUF = KB + VB;
    constexpr int KCH = DQK / 8, NKC = 64 * KCH, NVI = DV / 64;
    int tid = threadIdx.x; asm volatile("" : "+v"(tid));
    const int lane = tid & 63, r32 = lane & 31, hi = lane >> 5;
    const int rowsw = (r32 & 0x13) | ((r32 & 4) << 1) | ((r32 & 8) >> 1);
    const int kc0 = tid, kc1 = tid + 512; const bool k1v = kc1 < NKC;
    typedef __attribute__((address_space(1))) const char gcc_t;
    gcc_t* Kgb = (gcc_t*)Kg; gcc_t* Vgb = (gcc_t*)Vg;
    const unsigned ko0 = (unsigned)((kc0 / KCH) * DQK + (kc0 % KCH) * 8) * 2u; const int kl0 = (kc0 / KCH) * KSTR + (kc0 % KCH) * 16;
    const unsigned ko1 = (unsigned)((kc1 / KCH) * DQK + (kc1 % KCH) * 8) * 2u; const int kl1 = (kc1 / KCH) * KSTR + (kc1 % KCH) * 16;
    unsigned vo[NVI]; int vl[NVI];
#pragma unroll
    for (int i = 0; i < NVI; ++i) { const int c = tid + 512 * i, d = c >> 3, vc = c & 7; vo[i] = (unsigned)(d * vstride + vc * 8) * 2u; vl[i] = KB + d * VSTR + vc * 16; }
    u32x4 kreg0, kreg1 = {0u, 0u, 0u, 0u}, vreg[NVI];
#define ATT_LOAD(t) do { gcc_t* kt_ = Kgb + (size_t)(t) * 64 * DQK * 2; gcc_t* vt_ = Vgb + (size_t)(t) * 128; \
        kreg0 = *(const __attribute__((address_space(1))) u32x4*)(kt_ + ko0); if (k1v) kreg1 = *(const __attribute__((address_space(1))) u32x4*)(kt_ + ko1); \
        _Pragma("unroll") for (int i_ = 0; i_ < NVI; ++i_) vreg[i_] = *(const __attribute__((address_space(1))) u32x4*)(vt_ + vo[i_]); } while (0)
#define ATT_STORE(bo) do { *(LAS u32x4*)(lds + (bo) + kl0) = kreg0; if (k1v) *(LAS u32x4*)(lds + (bo) + kl1) = kreg1; \
        _Pragma("unroll") for (int i_ = 0; i_ < NVI; ++i_) *(LAS u32x4*)(lds + (bo) + vl[i_]) = vreg[i_]; } while (0)
    ATT_LOAD(0); ATT_STORE(0); __syncthreads();
    float m = 0.f, l = 0.f; bool shifted = false;
#pragma unroll
    for (int dd = 0; dd < ND; ++dd)
#pragma unroll
        for (int r = 0; r < 16; ++r) o[dd][r] = 0.f;
    for (int t = 0; t < ntile; ++t) {
        const int cur = (t & 1) * BUF;
        if (t + 1 < ntile) ATT_LOAD(t + 1);
        if (t < mynt) { SrcLds<KSTR, VSTR> src{lds + cur + rowsw * KSTR + hi * 16, lds + cur + KB + r32 * VSTR + hi * 16}; attn_tile<NS, ND>(q, o, shifted, m, l, src, min(64, kvlen - 64 * t), hi); }
        if (t + 1 < ntile) ATT_STORE(((t + 1) & 1) * BUF);
        __syncthreads();
    }
#undef ATT_LOAD
#undef ATT_STORE
    lsum = half_sum(l);
}
template <int ND>
__device__ __forceinline__ void attn_store(const f32x16 (&o)[ND], float lsum, bf16* orow, int hi, bool valid) {
    const float inv = 1.0f / lsum;
    if (valid) {
#pragma unroll
        for (int dd = 0; dd < ND; ++dd)
#pragma unroll
            for (int rg = 0; rg < 4; ++rg) { u32x2 w; w.x = pk2(o[dd][4 * rg] * inv, o[dd][4 * rg + 1] * inv); w.y = pk2(o[dd][4 * rg + 2] * inv, o[dd][4 * rg + 3] * inv);
                *(u32x2*)(orow + 32 * dd + 8 * rg + 4 * hi) = w; }
    }
}
__device__ __forceinline__ void load_q_mla(bf16x8 (&q)[6], const bf16* qp  , int hi, const float* gqn, const float* gqr, const float* ropep  ) {
    u32x4 raw[6];
#pragma unroll
    for (int s = 0; s < 6; ++s) raw[s] = *(const u32x4*)(qp + 16 * s + 8 * hi);
    float x[6][8];
#pragma unroll
    for (int s = 0; s < 6; ++s) { x[s][0] = bflo(raw[s].x); x[s][1] = bfhi(raw[s].x); x[s][2] = bflo(raw[s].y); x[s][3] = bfhi(raw[s].y);
        x[s][4] = bflo(raw[s].z); x[s][5] = bfhi(raw[s].z); x[s][6] = bflo(raw[s].w); x[s][7] = bfhi(raw[s].w); }
    float ss = 0.f, sr = 0.f;
#pragma unroll
    for (int s = 0; s < 4; ++s)
#pragma unroll
        for (int j = 0; j < 8; ++j) ss += x[s][j] * x[s][j];
#pragma unroll
    for (int j = 0; j < 8; ++j) sr += x[4][j] * x[4][j] + x[5][j] * x[5][j];
    ss = half_sum(ss); sr = half_sum(sr);
    const float rs = rsqrtf(ss * (1.0f / 64.0f) + EPS) * SC_MLA, rr = rsqrtf(sr * (1.0f / 32.0f) + EPS);
#pragma unroll
    for (int s = 0; s < 4; ++s)
#pragma unroll
        for (int j = 0; j < 8; ++j) x[s][j] *= rs * gqn[16 * s + 8 * hi + j];
#pragma unroll
    for (int j = 0; j < 8; ++j) { const int i = 8 * hi + j; const float a1 = x[4][j] * rr * gqr[i], a2 = x[5][j] * rr * gqr[16 + i];
        const float c = ropep[2 * i], sn = ropep[2 * i + 1]; x[4][j] = (a1 * c - a2 * sn) * SC_MLA; x[5][j] = (a1 * sn + a2 * c) * SC_MLA; }
#pragma unroll
    for (int s = 0; s < 6; ++s) { u32x4 w; w.x = pk2(x[s][0], x[s][1]); w.y = pk2(x[s][2], x[s][3]); w.z = pk2(x[s][4], x[s][5]); w.w = pk2(x[s][6], x[s][7]); q[s] = __builtin_bit_cast(bf16x8, w); }
}
__device__ __forceinline__ void load_q_mem(bf16x8 (&q)[8], const bf16* qp  , int hi, const float* gq) {
    u32x4 raw[8];
#pragma unroll
    for (int s = 0; s < 8; ++s) raw[s] = *(const u32x4*)(qp + 16 * s + 8 * hi);
    float ss = 0.f;
#pragma unroll
    for (int s = 0; s < 8; ++s) { const float a0 = bflo(raw[s].x), a1 = bfhi(raw[s].x), a2 = bflo(raw[s].y), a3 = bfhi(raw[s].y), a4 = bflo(raw[s].z), a5 = bfhi(raw[s].z), a6 = bflo(raw[s].w), a7 = bfhi(raw[s].w);
        ss += (a0 * a0 + a1 * a1) + (a2 * a2 + a3 * a3) + (a4 * a4 + a5 * a5) + (a6 * a6 + a7 * a7); }
    ss = half_sum(ss);
    const float rs = rsqrtf(ss * (1.0f / 128.0f) + EPS) * SC_MEM;
#pragma unroll
    for (int s = 0; s < 8; ++s) { const float* g = gq + 16 * s + 8 * hi; u32x4 w;
        w.x = pk2(bflo(raw[s].x) * rs * g[0], bfhi(raw[s].x) * rs * g[1]); w.y = pk2(bflo(raw[s].y) * rs * g[2], bfhi(raw[s].y) * rs * g[3]);
        w.z = pk2(bflo(raw[s].z) * rs * g[4], bfhi(raw[s].z) * rs * g[5]); w.w = pk2(bflo(raw[s].w) * rs * g[6], bfhi(raw[s].w) * rs * g[7]);
        q[s] = __builtin_bit_cast(bf16x8, w); }
}

__device__ __forceinline__ void skinny_gemm(const bf16* A  , const bf16* Bt, int N, int K, const EpiU& E, int gw, int NGW, int lane) {
    const int nwu = N >> 1; const int fr = lane & 15, fq = lane >> 4;
#pragma unroll 1
    for (int wu = gw; wu < nwu; wu += NGW) {
        const int rb = wu & 7, cb = wu >> 3;
        const bf16* ap = A + (size_t)(16 * rb + fr) * K + 8 * fq; const bf16* bp = Bt + (size_t)(16 * cb + fr) * K + 8 * fq;
        pg8::f32x4 acc = {0.f, 0.f, 0.f, 0.f};
        if ((K & 511) == 0) {
#pragma unroll 1
            for (int k0 = 0; k0 < K; k0 += 512) {
                bf16x8 a[16], w[16];
#pragma unroll
                for (int i = 0; i < 16; ++i) { a[i] = *(const bf16x8*)(ap + k0 + 32 * i); w[i] = *(const bf16x8*)(bp + k0 + 32 * i); }
#pragma unroll
                for (int i = 0; i < 16; ++i) acc = __builtin_amdgcn_mfma_f32_16x16x32_bf16(w[i], a[i], acc, 0, 0, 0);
            }
        } else {
#pragma unroll 1
            for (int k0 = 0; k0 < K; k0 += 256) {
                bf16x8 a[8], w[8];
#pragma unroll
                for (int i = 0; i < 8; ++i) { a[i] = *(const bf16x8*)(ap + k0 + 32 * i); w[i] = *(const bf16x8*)(bp + k0 + 32 * i); }
#pragma unroll
                for (int i = 0; i < 8; ++i) acc = __builtin_amdgcn_mfma_f32_16x16x32_bf16(w[i], a[i], acc, 0, 0, 0);
            }
        }
        const int row = TP + 16 * rb + fr, col = 16 * cb + 4 * fq;
        if (E.mode == 1) {
            bf16* xp = E.xb + (size_t)row * 1024 + col; const u32x2 bw = *(const u32x2*)xp; const f32x4 bs = {bflo(bw.x), bfhi(bw.x), bflo(bw.y), bfhi(bw.y)}; const f32x4 x = bs + acc;
            if (E.out) *(f32x4*)((float*)E.out + (size_t)row * 1024 + col) = x; else { u32x2 wv; wv.x = pk2(x[0], x[1]); wv.y = pk2(x[2], x[3]); *(u32x2*)xp = wv; }
            float s2 = (x[0] * x[0] + x[1] * x[1]) + (x[2] * x[2] + x[3] * x[3]);
            s2 = half_sum(swap16_sum(s2));
            if (fq == 0) unsafeAtomicAdd(E.ssout + row, s2);
        } else {
            const float rs = E.ss ? rsqrtf(E.ss[row] * E.ssdiv + EPS) : 1.0f; f32x4 v = acc * rs;
            if (E.relu2) { v[0] = fmaxf(v[0], 0.f); v[1] = fmaxf(v[1], 0.f); v[2] = fmaxf(v[2], 0.f); v[3] = fmaxf(v[3], 0.f); v = v * v; }
            u32x2 wv; wv.x = pk2(v[0], v[1]); wv.y = pk2(v[2], v[3]); *(u32x2*)((bf16*)E.out + (size_t)row * E.ldc + col) = wv;
        }
    }
}

__device__ __forceinline__ void conv_w(const float* W, int Nsrc, int K, int ndst, int blk, int sblk, int soff, const float* gain, bf16* dst, LAS float* scr, int gw, int NGW, int lane) {
    const int nblk = ndst / 32, nitems = (K / 64) * nblk;
#pragma unroll 1
    for (int it = gw; it < nitems; it += NGW) {
        const int kb = it / nblk, nb = it % nblk, k0 = 64 * kb, n0 = 32 * nb;
        const int sc0 = blk > 0 ? (n0 / blk) * sblk + soff + (n0 % blk)
                                : (((nb >> 3) * 4 + (nb & 3)) * 128 + 32 * ((nb >> 2) & 1));
        float wv[32];
#pragma unroll
        for (int i = 0; i < 32; ++i) wv[i] = W[(size_t)(k0 + 2 * i + (lane >> 5)) * Nsrc + sc0 + (lane & 31)];
        if (gain) {
#pragma unroll
            for (int i = 0; i < 32; ++i) wv[i] *= gain[k0 + 2 * i + (lane >> 5)];
        }
#pragma unroll
        for (int i = 0; i < 32; ++i) scr[(2 * i + (lane >> 5)) * 33 + (lane & 31)] = wv[i];
        asm volatile("s_waitcnt lgkmcnt(0)" ::: "memory");
        const int c = lane & 7;
#pragma unroll
        for (int j = 0; j < 4; ++j) { const int n = (lane >> 3) + 8 * j; const LAS float* s = scr + (8 * c) * 33 + n;
            u32x4 o; o.x = pk2(s[0 * 33], s[1 * 33]); o.y = pk2(s[2 * 33], s[3 * 33]); o.z = pk2(s[4 * 33], s[5 * 33]); o.w = pk2(s[6 * 33], s[7 * 33]);
            *(u32x4*)(dst + (size_t)(n0 + n) * K + k0 + 8 * c) = o; }
        asm volatile("s_waitcnt lgkmcnt(0)" ::: "memory");
    }
}
__device__ __forceinline__ float row_to_bf16(const float* xr, bf16* orow, int lane) {
    f32x4 v[4]; float s = 0.f;
#pragma unroll
    for (int j = 0; j < 4; ++j) { v[j] = ((const f32x4*)xr)[lane + 64 * j]; s += (v[j][0] * v[j][0] + v[j][1] * v[j][1]) + (v[j][2] * v[j][2] + v[j][3] * v[j][3]); }
#pragma unroll
    for (int j = 0; j < 4; ++j) { u32x2 w; w.x = pk2(v[j][0], v[j][1]); w.y = pk2(v[j][2], v[j][3]); ((u32x2*)orow)[lane + 64 * j] = w; }
    return wave_sum(s);
}

#define RLX_AGENT __ATOMIC_RELAXED, __HIP_MEMORY_SCOPE_AGENT
#define XB_TMO      128
#define XB_XCNT(j)  (256  + 64 * (j))
#define XB_XSUB(j)  (1280 + 64 * (j))
#define XB_XGEN(j)  (2304 + 64 * (j))
#define XB_TOP      3328
#define XB_TOPGEN   3392
#define XCD_BAR_WORDS 3456
#define XB_SPIN_CAP (1u << 18)

__device__ __forceinline__ unsigned xb_ld(unsigned* p)              { return __hip_atomic_load(p, __ATOMIC_RELAXED, __HIP_MEMORY_SCOPE_AGENT); }
__device__ __forceinline__ unsigned xb_add(unsigned* p, unsigned v) { return __hip_atomic_fetch_add(p, v, __ATOMIC_RELAXED, __HIP_MEMORY_SCOPE_AGENT); }
__device__ __forceinline__ unsigned xb_xcc_id() { return (unsigned)__builtin_amdgcn_s_getreg((3 << 11) | 20) & 0xFu; }
#define XB_SPIN(cond, bar) do { unsigned _sp = 0; while (cond) { __builtin_amdgcn_s_sleep(1); \
    if ((++_sp & 255u) == 0u) { if (xb_ld(&(bar)[XB_TMO])) break; if (_sp > XB_SPIN_CAP) { atomicAdd(&(bar)[XB_TMO], 1u); break; } } } } while (0)

struct XcdBarrier {
    unsigned* bar; unsigned x;
    volatile LAS unsigned* st;
};

__device__ __forceinline__ XcdBarrier xcd_barrier_post(unsigned* bar, volatile LAS unsigned* st) {
    XcdBarrier b; b.bar = bar; b.x = xb_xcc_id(); b.st = st;
    if (threadIdx.x == 0) (void)xb_add(&bar[XB_XCNT(b.x)], 1u);
    return b;
}
__device__ __forceinline__ void xcd_barrier_complete(unsigned* bar, unsigned x, unsigned& nloc, unsigned& nx) {
    const unsigned G = gridDim.x * gridDim.y * gridDim.z;
    unsigned sum, cnt, mine, sp = 0u;
    for (;;) {
        sum = 0u; cnt = 0u; mine = 0u;
#pragma unroll
        for (unsigned j = 0; j < 16; ++j) { const unsigned c = xb_ld(&bar[XB_XCNT(j)]); sum += c; cnt += (c > 0u) ? 1u : 0u; mine = (j == x) ? c : mine; }
        if (sum == G) break;
        __builtin_amdgcn_s_sleep(1);
        if ((++sp & 255u) == 0u) { if (xb_ld(&bar[XB_TMO])) break; if (sp > XB_SPIN_CAP) { atomicAdd(&bar[XB_TMO], 1u); break; } }
    }
    nloc = mine > 0u ? mine : 1u; nx = cnt > 0u ? cnt : 1u;
}

__device__ __forceinline__ void xcd_barrier(const XcdBarrier& b) {
    asm volatile("s_waitcnt vmcnt(0)" ::: "memory");
    __syncthreads();
    if (threadIdx.x == 0) {
        unsigned* bar = b.bar;
        __builtin_amdgcn_s_waitcnt(0);
        unsigned nloc = b.st[0], nx = b.st[1];
        if (nloc == 0u) { xcd_barrier_complete(bar, b.x, nloc, nx); b.st[0] = nloc; b.st[1] = nx; }
        const unsigned old = xb_add(&bar[XB_XSUB(b.x)], 1u);
        const unsigned gen = old / nloc;
        if (old + 1u == (gen + 1u) * nloc) {
            __builtin_amdgcn_fence(__ATOMIC_RELEASE, "agent");
            asm volatile("s_waitcnt vmcnt(0)" ::: "memory");
            const unsigned og = xb_add(&bar[XB_TOP], 1u);
            const unsigned tg = og / nx;
            if (og + 1u == (tg + 1u) * nx) xb_add(&bar[XB_TOPGEN], 1u);
            else XB_SPIN(xb_ld(&bar[XB_TOPGEN]) == tg, bar);
            __builtin_amdgcn_fence(__ATOMIC_ACQUIRE, "agent");
            xb_add(&bar[XB_XGEN(b.x)], 1u);
            asm volatile("s_waitcnt vmcnt(0)" ::: "memory");
        } else {
            XB_SPIN(xb_ld(&bar[XB_XGEN(b.x)]) == gen, bar);
            __builtin_amdgcn_fence(__ATOMIC_ACQUIRE, "agent");
            asm volatile("s_waitcnt vmcnt(0)" ::: "memory");
        }
    }
    __syncthreads();
}


#define SS ((float*)(ws + OFF_SS))
#define MSS ((float*)(ws + OFF_MSS))
#define ROPE ((float*)(ws + OFF_ROPE))
#define WMKV ((bf16*)(ws + OFF_WMKV))
#define MEMB ((bf16*)(ws + OFF_MEMB))
#define MKVRAW ((float*)(ws + OFF_MKVRAW))
#define MK ((bf16*)(ws + OFF_MK))
#define MVT ((bf16*)(ws + OFF_MVT))
#define XB ((bf16*)(ws + OFF_XB))
#define LATC ((bf16*)(ws + OFF_LATC))
#define KR ((bf16*)(ws + OFF_KR))
#define UG ((bf16*)(ws + OFF_UG))
#define VG ((bf16*)(ws + OFF_VG))
#define Zb ((bf16*)(ws + OFF_Z))
#define CQ ((bf16*)(ws + OFF_CQ))
#define Hb ((bf16*)(ws + OFF_H))
#define QRAW ((bf16*)(ws + OFF_QRAW))
#define KRAW ((bf16*)(ws + OFF_KRAW))
#define QMRAW ((bf16*)(ws + OFF_QMRAW))
#define OM ((bf16*)(ws + OFF_OM))
#define VT ((bf16*)(ws + OFF_VT))
#define KH ((bf16*)(ws + OFF_KH))
#define KHS ((bf16*)(ws + OFF_KHS))
#define MIX ((bf16*)(ws + OFF_MIX))
#define HID ((bf16*)(ws + OFF_HID))
#ifndef EN_PRO
#define EN_PRO 1
#endif
#ifndef EN_GEMM
#define EN_GEMM 1
#endif
#ifndef EN_E1
#define EN_E1 1
#endif
#ifndef EN_E2
#define EN_E2 1
#endif
#ifndef EN_KB
#define EN_KB 1
#endif
#ifndef EN_ATT
#define EN_ATT 1
#endif
#ifndef EN_MATT
#define EN_MATT 1
#endif
__global__ void __launch_bounds__(512, 2) fwd_kernel(Params P) {
    extern __shared__ __attribute__((aligned(16))) unsigned char lds_raw[];
    LAS unsigned char* lds = (LAS unsigned char*)lds_raw;
    LAS char* ldc_ = (LAS char*)lds_raw;
    const int G = gridDim.x;
    float* dout = P.out;
    cg::grid_group grid = cg::this_grid();
    volatile LAS unsigned* MISC = (volatile LAS unsigned*)(lds + 131072 + 320);
    if (threadIdx.x < 32) MISC[threadIdx.x] = 0u;
    __syncthreads();
    XcdBarrier bar; bar.bar = (unsigned*)(P.ws + OFF_CTL); bar.x = 0; bar.st = MISC + 8;
    if (P.ph_hi - P.ph_lo > 1) bar = xcd_barrier_post((unsigned*)(P.ws + OFF_CTL), MISC + 8);

#ifndef REPEAT_SP
#define REPEAT_SP 0
#endif
#ifndef DOUBLE_SYNC
#define DOUBLE_SYNC 0
#endif
    int redone = 0; (void)redone;
#pragma unroll 1
    for (int ph = P.ph_lo; ph < P.ph_hi; ++ph) {
        int bid = blockIdx.x; asm volatile("" : "+s"(bid));
        unsigned char* ws = P.ws; asm volatile("" : "+s"(ws));
        const int NGW = G * 8, GT = G * 512;
#define PHASE_IDS int tid = threadIdx.x; asm volatile("" : "+v"(tid)); const int lane = tid & 63, wid = __builtin_amdgcn_readfirstlane(tid >> 6); const int gw = bid * 8 + wid, gtid = bid * 512 + tid; (void)gw; (void)gtid; (void)lane;
        const int l = (ph - 1) / 11, sp = (ph == 0) ? 0 : ((ph - 1) % 11) + 1;
        if (sp == 4 && !(REPEAT_SP == 4)) continue;
        unsigned char* wl = ws + OFF_W + (size_t)l * W_LAYER;
#define WIN ((bf16*)(wl + W_WIN))
#define WUQ ((bf16*)(wl + W_WUQ))
#define WK ((bf16*)(wl + W_WK))
#define WVT ((bf16*)(wl + W_WVT))
#define WOUT ((bf16*)(wl + W_WOUT))
#define WMQ ((bf16*)(wl + W_WMQ))
#define WMO ((bf16*)(wl + W_WMO))
#define WFF1 ((bf16*)(wl + W_FF1))
#define WFF2 ((bf16*)(wl + W_FF2))
#define SS1 (SS + (size_t)(3 * l) * TT)
#define SS2 (SS + (size_t)(3 * l + 1) * TT)
#define SS3 (SS + (size_t)(3 * l + 2) * TT)
#define SS1n (SS + (size_t)(3 * ((l + 1) & 1)) * TT)

        if (sp == 0 && EN_PRO) {
            PHASE_IDS
            LAS float* scr = (LAS float*)(lds + wid * 16384);
            int rot = 0;
#define CONVW(src, Nsrc, K, ndst, blk, sblk, soff, gain, dst) do { int gwr = gw - rot % NGW; if (gwr < 0) gwr += NGW; conv_w(src, Nsrc, K, ndst, blk, sblk, soff, gain, dst, scr, gwr, NGW, lane); rot += ((K) / 64) * ((ndst) / 32); } while (0)
#pragma unroll 1
            for (int ll = 0; ll < 2; ++ll) {
                unsigned char* w2 = ws + OFF_W + (size_t)ll * W_LAYER;
                CONVW(P.in[35] + (size_t)ll * 1024 * 4096, 4096, 1024, 4096, 4096, 4096, 0, P.in[34] + ll * 1024, (bf16*)(w2 + W_FF1));
                CONVW(P.in[36] + (size_t)ll * 4096 * 1024, 1024, 4096, 1024, 1024, 1024, 0, nullptr, (bf16*)(w2 + W_FF2));
                CONVW(P.in[9] + (size_t)ll * 1024 * 1440, 1440, 1024, 1440, 1440, 1440, 0, P.in[8] + ll * 1024, (bf16*)(w2 + W_WIN));
                CONVW(P.in[18] + (size_t)ll * 256 * 768, 768, 256, 768, 768, 768, 0, P.in[17] + ll * 256, (bf16*)(w2 + W_WUQ));
                CONVW(P.in[20] + (size_t)ll * 128 * 1024, 1024, 128, 512, -1, 128, 0, nullptr, (bf16*)(w2 + W_WK));
                CONVW(P.in[20] + (size_t)ll * 128 * 1024, 1024, 128, 512, 64, 128, 64, nullptr, (bf16*)(w2 + W_WVT));
                CONVW(P.in[25] + (size_t)ll * 1024 * 1024, 1024, 1024, 1024, 1024, 1024, 0, nullptr, (bf16*)(w2 + W_WOUT));
                CONVW(P.in[28] + (size_t)ll * 1024 * 512, 512, 1024, 512, 512, 512, 0, P.in[26] + ll * 1024, (bf16*)(w2 + W_WMQ));
                CONVW(P.in[29] + (size_t)ll * 1024 * 512, 512, 1024, 512, 512, 512, 0, P.in[27] + ll * 1024, WMKV + (size_t)(ll * 1024) * 1024);
                CONVW(P.in[30] + (size_t)ll * 1024 * 512, 512, 1024, 512, 512, 512, 0, P.in[27] + ll * 1024, WMKV + (size_t)(ll * 1024 + 512) * 1024);
                CONVW(P.in[31] + (size_t)ll * 512 * 1024, 1024, 512, 1024, 1024, 1024, 0, nullptr, (bf16*)(w2 + W_WMO));
#pragma unroll 1
                for (int i = gtid; i < 96 * 1024 / 8; i += GT) ((u32x4*)((bf16*)(w2 + W_WIN) + (size_t)1440 * 1024))[i] = (u32x4){0u, 0u, 0u, 0u};
            }
#pragma unroll 1
            for (int lb = 0; lb < 16; ++lb) { const int ll = lb >> 3, b2 = lb & 7;
                CONVW(P.in[7] + (size_t)(ll * 8 + b2) * 256 * 512, 512, 256, 512, 512, 512, 0, nullptr, MVT + (size_t)((ll * 12 + 4 + b2) * 4) * 128 * 256); }
#undef CONVW
#pragma unroll 1
            for (int row = gw; row < TV; row += 2 * NGW) {
                const int row2 = row + NGW; const bool has2 = row2 < TV;
                const float* xr = row < TP ? P.in[0] + (size_t)row * 1024 : P.in[1] + (size_t)(row - TP) * 1024;
                const float* xr2 = !has2 ? xr : row2 < TP ? P.in[0] + (size_t)row2 * 1024 : P.in[1] + (size_t)(row2 - TP) * 1024;
                f32x4 va[4], vb[4];
#pragma unroll
                for (int j = 0; j < 4; ++j) { va[j] = ((const f32x4*)xr)[lane + 64 * j]; vb[j] = ((const f32x4*)xr2)[lane + 64 * j]; }
                float sa = 0.f, sb = 0.f;
#pragma unroll
                for (int j = 0; j < 4; ++j) { sa += (va[j][0] * va[j][0] + va[j][1] * va[j][1]) + (va[j][2] * va[j][2] + va[j][3] * va[j][3]);
                    sb += (vb[j][0] * vb[j][0] + vb[j][1] * vb[j][1]) + (vb[j][2] * vb[j][2] + vb[j][3] * vb[j][3]);
                    u32x2 w; w.x = pk2(va[j][0], va[j][1]); w.y = pk2(va[j][2], va[j][3]); ((u32x2*)(XB + (size_t)row * 1024))[lane + 64 * j] = w;
                    if (has2) { w.x = pk2(vb[j][0], vb[j][1]); w.y = pk2(vb[j][2], vb[j][3]); ((u32x2*)(XB + (size_t)row2 * 1024))[lane + 64 * j] = w; } }
                sa = wave_sum(sa); sb = wave_sum(sb);
                if (lane == 0) { SS[row] = sa; if (has2) SS[row2] = sb; }
            }
            { int i = TV + gtid; while (i < 6 * TT) { SS[i] = 0.f; i += GT; asm volatile("" : "+v"(i)); } }
#pragma unroll 1
            for (int row = gw; row < 1024; row += NGW) { const float s = row_to_bf16(P.in[2] + (size_t)row * 1024, MEMB + (size_t)row * 1024, lane); if (lane == 0) MSS[row] = s; }
#pragma unroll 1
            for (int it = gw; it < 16 * 128; it += NGW) {
                const int k = it & 15, pos = (it >> 4) * 64 + lane, k3 = k & 3, k2 = k >> 2;
                const double b0 = k3 == 0 ? 1.0 : k3 == 1 ? 0.5623413251903491 : k3 == 2 ? 0.31622776601683794 : 0.1778279410038923;
                const double d0 = k2 == 0 ? 1.0 : k2 == 1 ? 0.1 : k2 == 2 ? 0.01 : 0.001;
                const double ang = (double)pos * (b0 * d0);
                const double kk = __builtin_rint(ang * 0.15915494309189535);
                const float r = (float)(ang - kk * 6.283185307179586);
                ROPE[2 * (pos * 16 + k)] = cosf(r); ROPE[2 * (pos * 16 + k) + 1] = sinf(r);
            }
#pragma unroll 1
            for (int row = gw; row < 2 * 8 * 256; row += NGW) {
                const int ll = row >> 11, b = (row >> 8) & 7, mm = row & 255, h = lane >> 4, d0 = 8 * (lane & 15);
                const float* ks = P.in[6] + (size_t)row * 512 + 8 * lane;
                const f32x4 k0 = *(const f32x4*)ks, k1 = *(const f32x4*)(ks + 4);
                u32x4 w; w.x = pk2(k0[0], k0[1]); w.y = pk2(k0[2], k0[3]); w.z = pk2(k1[0], k1[1]); w.w = pk2(k1[2], k1[3]);
                *(u32x4*)(MK + ((size_t)((ll * 12 + 4 + b) * 4 + h) * 256 + mm) * 128 + d0) = w;
            }
            __syncthreads();
        }

        {
            const int ng = !EN_GEMM ? 0 : (sp == 1) ? (l == 0 ? 2 : 1) : (sp == 3) ? 3 : (sp == 6 || sp == 7 || sp == 9 || sp == 10 || sp == 11) ? 1 : 0;
#pragma unroll 1
            for (int gi = 0; gi < ng; ++gi) {
                pg8::Gemm g; bool sk = true; EpiU E; E.mode = 0; E.relu2 = 0; E.out = nullptr; E.ldc = 0; E.ss = nullptr; E.ssdiv = 1.0f / 1024.0f; E.ssout = nullptr; E.base_p = nullptr; E.base_s = nullptr; E.xb = nullptr; E.gkn = nullptr; E.kr = nullptr; E.kh = nullptr; E.khs = nullptr;
                if (sp == 1 && gi == 0) { g = pg8::Gemm{XB, WIN, TP, 1536, 1024}; E.out = Hb; E.ldc = 1536; E.ss = SS1; }
                else if (sp == 1) { g = pg8::Gemm{MEMB, WMKV, 1024, 2048, 1024}; sk = false; E.mode = 2; E.out = MKVRAW; E.ldc = 2048; E.ss = MSS; }
                else if (sp == 3 && gi == 0) { g = pg8::Gemm{CQ, WUQ, TP, 768, 256}; E.out = QRAW; E.ldc = 768; }
                else if (sp == 3 && gi == 1) { g = pg8::Gemm{LATC, WK, LR, 512, 128}; sk = false; E.mode = 3; E.gkn = P.in[23] + l * 64; E.kr = KR; E.kh = KH; E.khs = KHS; }
                else if (sp == 3) { g = pg8::Gemm{WVT, LATC, 512, LR, 128}; sk = false; E.out = VT; E.ldc = LR; }
                else if (sp == 6) { g = pg8::Gemm{MIX, WOUT, TP, 1024, 1024}; E.mode = 1; E.out = nullptr; E.ldc = 1024; E.ssout = SS2; E.xb = XB; }
                else if (sp == 7) { g = pg8::Gemm{XB, WMQ, TP, 512, 1024}; E.out = QMRAW; E.ldc = 512; E.ss = SS2; }
                else if (sp == 9) { g = pg8::Gemm{OM, WMO, TP, 1024, 512}; E.mode = 1; E.out = nullptr; E.ldc = 1024; E.ssout = SS3; E.xb = XB; }
                else if (sp == 10) { g = pg8::Gemm{XB, WFF1, TP, 4096, 1024}; E.out = HID; E.ldc = 4096; E.ss = SS3; E.relu2 = 1; }
                else { g = pg8::Gemm{HID, WFF2, TP, 1024, 4096}; E.mode = 1; E.out = l == 1 ? dout : nullptr; E.ldc = 1024; E.ssout = SS1n; E.xb = XB; }
                const int rotc = (sp == 3 && (G & 7) == 0) ? (bid + G - (gi == 1 ? G / 2 : gi == 2 ? (3 * G) / 4 : 0)) % G : bid;
                pg8::StaticOrder S; S.init(g.M, g.N, G, rotc);
                if (E.mode != 2) { EpiP Ep; Ep.mode = E.mode; Ep.relu2 = E.relu2; Ep.out = E.out; Ep.ldc = E.ldc; Ep.ss = E.ss; Ep.ssdiv = E.ssdiv; Ep.ssout = E.ssout; Ep.xb = E.xb;
                    Ep.gkn = E.gkn; Ep.kr = E.kr; Ep.kh = E.kh; Ep.khs = E.khs;
                    pg8::gemm_phase<EpiP, pg8::StaticOrder, true, true>(lds, g, S, Ep); }
                else pg8::gemm_phase<EpiU, pg8::StaticOrder, true, true>(lds, g, S, E);
                __syncthreads();
                if (sk) { PHASE_IDS skinny_gemm(g.A + (size_t)TP * g.K, g.Bt, g.N, g.K, E, gw, NGW, lane); }
            }
        }

        if (sp == 2 && EN_E1) {
            PHASE_IDS
            const float* g_a = P.in[10] + l * 256; const float* g_kva = P.in[19] + l * 128; const float* g_kr = P.in[24] + l * 32;
            const f32x4 gA = *(const f32x4*)(g_a + 4 * lane), gKVA = *(const f32x4*)(g_kva + 4 * (lane & 31)), gKR = *(const f32x4*)(g_kr + 4 * (lane & 7));
            u32x2 cu = {0u, 0u}, cv = {0u, 0u}, ca = {0u, 0u}, cg_ = {0u, 0u}, cq = {0u, 0u}, cl = {0u, 0u}, ck = {0u, 0u};
            u32x2 nu = {0u, 0u}, nv = {0u, 0u}, na = {0u, 0u}, ng_ = {0u, 0u}, nq = {0u, 0u}, nl = {0u, 0u}, nk = {0u, 0u};
            if (gw < TV) { const bf16* h_ = Hb + (size_t)gw * 1536 + 4 * lane; cu = *(const u32x2*)(h_); cv = *(const u32x2*)(h_ + 256); ca = *(const u32x2*)(h_ + 512);
                cg_ = *(const u32x2*)(h_ + 768); cq = *(const u32x2*)(h_ + 1024); if (lane < 32) cl = *(const u32x2*)(h_ + 1280); if (lane < 8) ck = *(const u32x2*)(h_ + 1408); }
#pragma unroll 1
            for (int row = gw; row < TV; row += NGW) {
                if (row + NGW < TV) { const bf16* h_ = Hb + (size_t)(row + NGW) * 1536 + 4 * lane; nu = *(const u32x2*)(h_); nv = *(const u32x2*)(h_ + 256); na = *(const u32x2*)(h_ + 512);
                    ng_ = *(const u32x2*)(h_ + 768); nq = *(const u32x2*)(h_ + 1024); if (lane < 32) nl = *(const u32x2*)(h_ + 1280); if (lane < 8) nk = *(const u32x2*)(h_ + 1408); }
                const bool samp = row >= TP;
                int b, t; if (!samp) { b = row >> 13; t = row & 8191; } else { b = (row - TP) >> 4; t = (row - TP) & 15; }
                const int pos = samp ? 1024 + t : t; const int c4 = 4 * lane;
                const float* rp = ROPE + (size_t)pos * 32 + 8 * (lane & 3); const f32x4 cs0 = *(const f32x4*)rp, cs1 = *(const f32x4*)(rp + 4);
                {
                    const u32x2 r = cu; u32x2 w; w.x = pk2(gelu_f(bflo(r.x)), gelu_f(bfhi(r.x))); w.y = pk2(gelu_f(bflo(r.y)), gelu_f(bfhi(r.y)));
                    *(u32x2*)(UG + (size_t)row * 256 + c4) = w; }
                {
                    const u32x2 r = cv; float v0 = gelu_f(bflo(r.x)), v1 = gelu_f(bfhi(r.x)), v2 = gelu_f(bflo(r.y)), v3 = gelu_f(bfhi(r.y));
                    const float rs = rsqrtf(wave_sum((v0 * v0 + v1 * v1) + (v2 * v2 + v3 * v3)) * (1.0f / 256.0f) + EPS); const f32x4 g = gA;
                    v0 *= rs * g[0]; v1 *= rs * g[1]; v2 *= rs * g[2]; v3 *= rs * g[3];
                    u32x2 w; w.x = pk2(v0, v1); w.y = pk2(v2, v3); *(u32x2*)(VG + (size_t)row * 256 + c4) = w;
                    if (samp) *(f32x4*)(dout + O_GVS + ((size_t)(l * 8 + b) * 16 + t) * 256 + c4) = (f32x4){v0, v1, v2, v3}; }
                {
                    const u32x2 a = ca, gt = cg_;
                    const float z0 = bflo(a.x) * sigm_f(bflo(gt.x)), z1 = bfhi(a.x) * sigm_f(bfhi(gt.x)), z2 = bflo(a.y) * sigm_f(bflo(gt.y)), z3 = bfhi(a.y) * sigm_f(bfhi(gt.y));
                    u32x2 w; w.x = pk2(z0, z1); w.y = pk2(z2, z3); *(u32x2*)(Zb + (size_t)row * 256 + c4) = w;
                    if (!samp) { if (t >= 8162) *(f32x4*)(dout + O_CONVP + ((size_t)(l * 4 + b) * 30 + (t - 8162)) * 256 + c4) = (f32x4){z0, z1, z2, z3}; }
                    else { *(f32x4*)(dout + O_CONVS + ((size_t)(l * 8 + b) * 30 + 14 + t) * 256 + c4) = (f32x4){z0, z1, z2, z3};
                           if (t < 14) *(f32x4*)(dout + O_CONVS + ((size_t)(l * 8 + b) * 30 + t) * 256 + c4) = *(const f32x4*)(P.in[5] + ((size_t)(l * 8 + b) * 30 + 16 + t) * 256 + c4); } }
                {
                    const u32x2 r = cq; float v0 = bflo(r.x), v1 = bfhi(r.x), v2 = bflo(r.y), v3 = bfhi(r.y);
                    const float rs = rsqrtf(wave_sum((v0 * v0 + v1 * v1) + (v2 * v2 + v3 * v3)) * (1.0f / 256.0f) + EPS);
                    u32x2 w; w.x = pk2(v0 * rs, v1 * rs); w.y = pk2(v2 * rs, v3 * rs); *(u32x2*)(CQ + (size_t)row * 256 + c4) = w; }
                const size_t lrow = samp ? (size_t)TP + b * SKV + 1024 + t : (size_t)row;
                {
                    float v0 = 0.f, v1 = 0.f, v2 = 0.f, v3 = 0.f;
                    if (lane < 32) { const u32x2 r = cl; v0 = bflo(r.x); v1 = bfhi(r.x); v2 = bflo(r.y); v3 = bfhi(r.y); }
                    const float rs = rsqrtf(wave_sum((v0 * v0 + v1 * v1) + (v2 * v2 + v3 * v3)) * (1.0f / 128.0f) + EPS);
                    if (lane < 32) { const f32x4 g = gKVA; v0 *= rs * g[0]; v1 *= rs * g[1]; v2 *= rs * g[2]; v3 *= rs * g[3];
                        float* op = samp ? dout + O_LATS + ((size_t)(l * 8 + b) * 16 + t) * 128 : dout + O_LATP + ((size_t)(l * 4 + b) * 8192 + t) * 128;
                        *(f32x4*)(op + c4) = (f32x4){v0, v1, v2, v3}; u32x2 w; w.x = pk2(v0, v1); w.y = pk2(v2, v3); *(u32x2*)(LATC + lrow * 128 + c4) = w; } }
                {
                    float v0 = 0.f, v1 = 0.f, v2 = 0.f, v3 = 0.f;
                    if (lane < 8) { const u32x2 r = ck; v0 = bflo(r.x); v1 = bfhi(r.x); v2 = bflo(r.y); v3 = bfhi(r.y); }
                    const float rs = rsqrtf(wave_sum((v0 * v0 + v1 * v1) + (v2 * v2 + v3 * v3)) * (1.0f / 32.0f) + EPS);
                    if (lane < 8) { const f32x4 g = gKR; v0 *= rs * g[0]; v1 *= rs * g[1]; v2 *= rs * g[2]; v3 *= rs * g[3]; }
#define XOR4(v) __builtin_bit_cast(float, __builtin_amdgcn_ds_bpermute((lane ^ 4) << 2, __builtin_bit_cast(int, (v))))
                    const float o0 = XOR4(v0), o1 = XOR4(v1), o2 = XOR4(v2), o3 = XOR4(v3);
#undef XOR4
                    if (lane < 8) {
                        float r0, r1, r2, r3;
                        if (lane < 4) { r0 = v0 * cs0[0] - o0 * cs0[1]; r1 = v1 * cs0[2] - o1 * cs0[3]; r2 = v2 * cs1[0] - o2 * cs1[1]; r3 = v3 * cs1[2] - o3 * cs1[3]; }
                        else          { r0 = o0 * cs0[1] + v0 * cs0[0]; r1 = o1 * cs0[3] + v1 * cs0[2]; r2 = o2 * cs1[1] + v2 * cs1[0]; r3 = o3 * cs1[3] + v3 * cs1[2]; }
                        float* op = samp ? dout + O_KRS + ((size_t)(l * 8 + b) * 16 + t) * 32 : dout + O_KRP + ((size_t)(l * 4 + b) * 8192 + t) * 32;
                        *(f32x4*)(op + c4) = (f32x4){r0, r1, r2, r3}; u32x2 w; w.x = pk2(r0, r1); w.y = pk2(r2, r3); *(u32x2*)(KR + lrow * 32 + c4) = w; } }
                cu = nu; cv = nv; ca = na; cg_ = ng_; cq = nq; cl = nl; ck = nk;
            }
#pragma unroll 1
            for (int i = gtid; i < 8 * 1024 * 16; i += GT) { const int b = i >> 14, t = (i >> 4) & 1023, c = i & 15;
                const float* s = P.in[3] + ((size_t)(l * 8 + b) * 1024 + t) * 128 + 8 * c; const f32x4 a = *(const f32x4*)s, bb = *(const f32x4*)(s + 4);
                u32x4 w; w.x = pk2(a[0], a[1]); w.y = pk2(a[2], a[3]); w.z = pk2(bb[0], bb[1]); w.w = pk2(bb[2], bb[3]);
                *(u32x4*)(LATC + ((size_t)TP + b * SKV + t) * 128 + 8 * c) = w; }
#pragma unroll 1
            for (int i = gtid; i < 8 * 1024 * 4; i += GT) { const int b = i >> 12, t = (i >> 2) & 1023, c = i & 3;
                const float* s = P.in[4] + ((size_t)(l * 8 + b) * 1024 + t) * 32 + 8 * c; const f32x4 a = *(const f32x4*)s, bb = *(const f32x4*)(s + 4);
                u32x4 w; w.x = pk2(a[0], a[1]); w.y = pk2(a[2], a[3]); w.z = pk2(bb[0], bb[1]); w.w = pk2(bb[2], bb[3]);
                *(u32x4*)(KR + ((size_t)TP + b * SKV + t) * 32 + 8 * c) = w; }
            if (l == 0) {
#pragma unroll 1
                for (int it = gw; it < 2048; it += NGW) { const int ll = it >> 10, row = it & 1023, b = row >> 8, mm = row & 255, h = lane >> 4, d0 = 8 * (lane & 15);
                    const float* kp = MKVRAW + (size_t)row * 2048 + ll * 1024 + 8 * lane; const float* vp = kp + 512;
                    f32x4 k0 = *(const f32x4*)kp, k1 = *(const f32x4*)(kp + 4); const f32x4 v0 = *(const f32x4*)vp, v1 = *(const f32x4*)(vp + 4);
                    float s = (k0[0] * k0[0] + k0[1] * k0[1]) + (k0[2] * k0[2] + k0[3] * k0[3]) + (k1[0] * k1[0] + k1[1] * k1[1]) + (k1[2] * k1[2] + k1[3] * k1[3]);
                    s = sum16(s);
                    const float rs = rsqrtf(s * (1.0f / 128.0f) + EPS); const float* gk = P.in[33] + ll * 128 + d0;
                    const f32x4 g0 = *(const f32x4*)gk, g1 = *(const f32x4*)(gk + 4); k0 = k0 * rs * g0; k1 = k1 * rs * g1;
                    float* ok = dout + O_MKP + ((size_t)(ll * 4 + b) * 256 + mm) * 512 + 8 * lane; float* ov = dout + O_MVP + ((size_t)(ll * 4 + b) * 256 + mm) * 512 + 8 * lane;
                    *(f32x4*)ok = k0; *(f32x4*)(ok + 4) = k1; *(f32x4*)ov = v0; *(f32x4*)(ov + 4) = v1;
                    u32x4 w; w.x = pk2(k0[0], k0[1]); w.y = pk2(k0[2], k0[3]); w.z = pk2(k1[0], k1[1]); w.w = pk2(k1[2], k1[3]);
                    *(u32x4*)(MK + ((size_t)((ll * 12 + b) * 4 + h) * 256 + mm) * 128 + d0) = w;
                }
                LAS float* scr = (LAS float*)(lds + wid * 16384);
#pragma unroll 1
                for (int lb = 0; lb < 8; ++lb) { const int ll = lb >> 2, b2 = lb & 3; int gwr = gw - (lb * 64) % NGW; if (gwr < 0) gwr += NGW;
                    conv_w(MKVRAW + (size_t)(b2 * 256) * 2048 + ll * 1024 + 512, 2048, 256, 512, 512, 512, 0, nullptr, MVT + (size_t)((ll * 12 + b2) * 4) * 128 * 256, scr, gwr, NGW, lane); }
            }
        }

        if (sp == 3 && EN_E2) {
            PHASE_IDS
            constexpr int GV_OFF = 128 * 272;
#pragma unroll 1
            for (int g = 0; g < 4; ++g) {
                const float* wsg = P.in[11] + ((size_t)(l * 4 + g) * 128) * 128; const float* bsg = P.in[12] + (l * 4 + g) * 128;
#pragma unroll 1
                for (int c = tid; c < 128 * 16; c += 512) { const int i = c >> 4, j0 = (c & 15) * 8; const f32x4 a = *(const f32x4*)(wsg + i * 128 + j0), b2 = *(const f32x4*)(wsg + i * 128 + j0 + 4);
                    float e[8] = {a[0], a[1], a[2], a[3], b2[0], b2[1], b2[2], b2[3]};
#pragma unroll
                    for (int k = 0; k < 8; ++k) if (j0 + k > i) e[k] = 0.f;
                    u32x4 w; w.x = pk2(e[0], e[1]); w.y = pk2(e[2], e[3]); w.z = pk2(e[4], e[5]); w.w = pk2(e[6], e[7]);
                    *(LAS u32x4*)(lds + i * 272 + j0 * 2) = w; }
#pragma unroll 1
                for (int u = bid; u < 256 + 256; u += G) {
                    if (u >= 256 && !(G == 256 ? (u - 256 >= 224 && ((u - 256 - 224) >> 3) == g) : (u - 256 < 8))) continue;
                    const int row0 = u < 256 ? 128 * u : TP + 16 * ((u - 256) & 7), nrows = u < 256 ? 128 : 16;
#pragma unroll 1
                    for (int c = tid; c < 128 * 16; c += 512) { const int j = c >> 4, d0 = (c & 15) * 4; u32x2 v = {0u, 0u};
                        if (j < nrows) v = *(const u32x2*)(VG + (size_t)(row0 + j) * 256 + g * 64 + d0);
                        *(LAS bf16*)(lds + GV_OFF + (d0 + 0) * 272 + j * 2) = (bf16)(v.x & 0xffffu); *(LAS bf16*)(lds + GV_OFF + (d0 + 1) * 272 + j * 2) = (bf16)(v.x >> 16);
                        *(LAS bf16*)(lds + GV_OFF + (d0 + 2) * 272 + j * 2) = (bf16)(v.y & 0xffffu); *(LAS bf16*)(lds + GV_OFF + (d0 + 3) * 272 + j * 2) = (bf16)(v.y >> 16); }
                    __syncthreads();
                    if (wid * 16 < nrows) {
                        pg8::f32x4 acc[4];
#pragma unroll
                        for (int dt = 0; dt < 4; ++dt) acc[dt] = (pg8::f32x4){0.f, 0.f, 0.f, 0.f};
                        const int i = 16 * wid + (lane & 15), kb = lane >> 4, nks = (16 * wid + 15) / 32 + 1;
                        for (int ks = 0; ks < nks; ++ks) {
                            const bf16x8 a = *(const LAS bf16x8*)(lds + i * 272 + (32 * ks + 8 * kb) * 2);
#pragma unroll
                            for (int dt = 0; dt < 4; ++dt) { const bf16x8 bfr = *(const LAS bf16x8*)(lds + GV_OFF + (16 * dt + (lane & 15)) * 272 + (32 * ks + 8 * kb) * 2);
                                acc[dt] = __builtin_amdgcn_mfma_f32_16x16x32_bf16(bfr, a, acc[dt], 0, 0, 0); }
                        }
                        const int ii = 16 * wid + (lane & 15); const float bsi = bsg[ii];
#pragma unroll
                        for (int dt = 0; dt < 4; ++dt) { const int d = 16 * dt + 4 * (lane >> 4);
                            const u32x2 uu = *(const u32x2*)(UG + (size_t)(row0 + ii) * 256 + g * 64 + d);
                            u32x2 w; w.x = pk2((acc[dt][0] + bsi) * bflo(uu.x), (acc[dt][1] + bsi) * bfhi(uu.x)); w.y = pk2((acc[dt][2] + bsi) * bflo(uu.y), (acc[dt][3] + bsi) * bfhi(uu.y));
                            *(u32x2*)(MIX + (size_t)(row0 + ii) * 1024 + g * 64 + d) = w; }
                    }
                    __syncthreads();
                }
            }
            const float* dww = P.in[13] + (size_t)l * 31 * 256; const float* dwb = P.in[14] + l * 256; const float* lng = P.in[15] + l * 256; const float* lnb = P.in[16] + l * 256;
            const f32x4 bias = *(const f32x4*)(dwb + 4 * lane), gg = *(const f32x4*)(lng + 4 * lane), bb = *(const f32x4*)(lnb + 4 * lane);
#pragma unroll 1
            for (int u0 = bid; u0 < 1024 + 256; u0 += G) {
                int u = u0;
                if (u0 >= 1024) { const int j = u0 - 1024; if (G == 256 ? (j < 216 || j >= 224) : (j >= 8)) continue; u = 1024 + (j & 7); }
                const bool samp = u >= 1024; const int b = samp ? u - 1024 : u >> 8; const int zrow0 = samp ? TP + 16 * b : b * 8192 + 32 * (u & 255);
                const int ntok = samp ? 16 : 32; const bool zero_hist = !samp && (u & 255) == 0; const float* hist = samp ? P.in[5] + (size_t)(l * 8 + b) * 30 * 256 : nullptr;
                const int nrows = 30 + ntok;
#pragma unroll 1
                for (int c = tid; c < nrows * 32; c += 512) { const int rr = c >> 5, cc = (c & 31) * 8; u32x4 v = {0u, 0u, 0u, 0u};
                    if (rr < 30) { if (hist) { const f32x4 a = *(const f32x4*)(hist + rr * 256 + cc), b2 = *(const f32x4*)(hist + rr * 256 + cc + 4); v.x = pk2(a[0], a[1]); v.y = pk2(a[2], a[3]); v.z = pk2(b2[0], b2[1]); v.w = pk2(b2[2], b2[3]); }
                                   else if (!zero_hist) v = *(const u32x4*)(Zb + (size_t)(zrow0 - 30 + rr) * 256 + cc); }
                    else v = *(const u32x4*)(Zb + (size_t)(zrow0 + rr - 30) * 256 + cc);
                    *(LAS u32x4*)(lds + rr * 512 + cc * 2) = v; }
                __syncthreads();
                {
                    const int tpw = ntok >> 3;
                    const int c4 = 4 * lane; f32x4 acc[4];
#pragma unroll
                    for (int j = 0; j < 4; ++j) acc[j] = bias;
#pragma unroll 1
                    for (int k = 0; k < 31; ++k) { const f32x4 w = *(const f32x4*)(dww + k * 256 + c4);
#pragma unroll
                        for (int j = 0; j < 4; ++j) if (j < tpw) { const u32x2 z = *(const LAS u32x2*)(lds + (tpw * wid + j + k) * 512 + c4 * 2);
                            acc[j][0] += w[0] * bflo(z.x); acc[j][1] += w[1] * bfhi(z.x); acc[j][2] += w[2] * bflo(z.y); acc[j][3] += w[3] * bfhi(z.y); } }
#pragma unroll
                    for (int j = 0; j < 4; ++j) if (j < tpw) { const float mean = wave_sum((acc[j][0] + acc[j][1]) + (acc[j][2] + acc[j][3])) * (1.0f / 256.0f);
                        const f32x4 xc = acc[j] - mean; const float var = wave_sum((xc[0] * xc[0] + xc[1] * xc[1]) + (xc[2] * xc[2] + xc[3] * xc[3])) * (1.0f / 256.0f);
                        const float rs = rsqrtf(var + EPS); f32x4 y = xc * rs * gg + bb;
                        y[0] *= sigm_f(y[0]); y[1] *= sigm_f(y[1]); y[2] *= sigm_f(y[2]); y[3] *= sigm_f(y[3]);
                        u32x2 w2; w2.x = pk2(y[0], y[1]); w2.y = pk2(y[2], y[3]); *(u32x2*)(MIX + (size_t)(zrow0 + tpw * wid + j) * 1024 + 256 + c4) = w2; }
                }
                __syncthreads();
            }
        }

        if (false) {
            PHASE_IDS
            const float* gkn = P.in[23] + l * 64;
#pragma unroll 1
            for (int r = gw; r < LRV; r += NGW) {
                const u32x4 raw = *(const u32x4*)(KRAW + (size_t)r * 512 + 8 * lane);
                float x[8] = {bflo(raw.x), bfhi(raw.x), bflo(raw.y), bfhi(raw.y), bflo(raw.z), bfhi(raw.z), bflo(raw.w), bfhi(raw.w)};
                float s = 0.f;
#pragma unroll
                for (int j = 0; j < 8; ++j) s += x[j] * x[j];
                s = sum8(s);
                const float rs = rsqrtf(s * (1.0f / 64.0f) + EPS); const int hh = lane >> 3, d0 = 8 * (lane & 7);
                const f32x4 g0 = *(const f32x4*)(gkn + d0), g1 = *(const f32x4*)(gkn + d0 + 4);
                u32x4 w; w.x = pk2(x[0] * rs * g0[0], x[1] * rs * g0[1]); w.y = pk2(x[2] * rs * g0[2], x[3] * rs * g0[3]); w.z = pk2(x[4] * rs * g1[0], x[5] * rs * g1[1]); w.w = pk2(x[6] * rs * g1[2], x[7] * rs * g1[3]);
                bf16* dst;
                if (r < TP) { const int b = r >> 13, t = r & 8191; dst = KH + ((size_t)(b * 8 + hh) * 8192 + t) * 96; }
                else { const int rr = r - TP, b = rr / SKV, t = rr - b * SKV; dst = KHS + ((size_t)(b * 8 + hh) * KHS_T + t) * 96; }
                *(u32x4*)(dst + d0) = w;
                *(u32x2*)(dst + 64 + 4 * (lane & 7)) = *(const u32x2*)(KR + (size_t)r * 32 + 4 * (lane & 7));
            }
        }

        if (sp == 5 && EN_ATT) {
            PHASE_IDS
            const float* gqn = P.in[21] + l * 64; const float* gqr = P.in[22] + l * 32;
            const int r32 = lane & 31, hi = lane >> 5;
            const int vcu = (bid & 7) * 32 + (bid >> 3);
#pragma unroll 1
            for (int ui = 0;; ++ui) {
                int bh, qb;
                if (G == 256) { if (ui >= 4) break; const int xcd = bid & 7, v = bid >> 3, s = v & 15;
                    bh = 4 * xcd + 2 * (ui >> 1) + (v >> 4); qb = (ui & 1) ? 31 - s : s; }
                else { const int u = bid + ui * G; if (u >= 1024) break; bh = u >> 5; qb = u & 31; }
                const int b = bh >> 3, h = bh & 7; const int t = qb * 256 + wid * 32 + r32; const size_t row = (size_t)b * 8192 + t;
                bf16x8 q[6]; load_q_mla(q, QRAW + row * 768 + h * 96, hi, gqn, gqr, ROPE + (size_t)t * 32);
                f32x16 o[2]; float lsum;
                attn_block<96, 64>(ldc_, q, KH + (size_t)bh * 8192 * 96, VT + (size_t)(h * 64) * LR + (size_t)b * 8192, LR, 4 * qb + 4, 4 * qb + (wid >> 1) + 1, 1 << 30, o, lsum);
                attn_store<2>(o, lsum, MIX + row * 1024 + 512 + h * 64, hi, true);
            }
#pragma unroll 1
            for (int u = bid; u < 64; u += G) {
                const int b = u >> 3, h = u & 7, tq = min(r32, 15); const size_t row = (size_t)TP + b * 16 + tq;
                bf16x8 q[6]; load_q_mla(q, QRAW + row * 768 + h * 96, hi, gqn, gqr, ROPE + (size_t)(1024 + tq) * 32);
                f32x16 o[2]; float lsum;
                attn_block<96, 64>(ldc_, q, KHS + (size_t)(b * 8 + h) * KHS_T * 96, VT + (size_t)(h * 64) * LR + TP + b * SKV, LR, 17, wid == 0 ? 17 : 0, SKV, o, lsum);
                attn_store<2>(o, lsum, MIX + row * 1024 + 512 + h * 64, hi, wid == 0 && r32 < 16);
            }
        }

        if (sp == 8 && EN_MATT) {
            PHASE_IDS
            const float* gq = P.in[32] + l * 128; const int r32 = lane & 31, hi = lane >> 5;
#pragma unroll 1
            for (int u = bid; u < 512; u += G) {
                const int b = u >> 7, h = (u >> 5) & 3, qt = u & 31; const size_t row = (size_t)b * 8192 + qt * 256 + wid * 32 + r32;
                bf16x8 q[8]; load_q_mem(q, QMRAW + row * 512 + h * 128, hi, gq);
                f32x16 o[4]; float lsum;
                attn_block<128, 128>(ldc_, q, MK + (size_t)((l * 12 + b) * 4 + h) * 256 * 128, MVT + (size_t)((l * 12 + b) * 4 + h) * 128 * 256, 256, 4, 4, 1 << 30, o, lsum);
                attn_store<4>(o, lsum, OM + row * 512 + h * 128, hi, true);
            }
#pragma unroll 1
            for (int u = bid; u < 32; u += G) {
                const int b = u >> 2, h = u & 3, tq = min(r32, 15); const size_t row = (size_t)TP + b * 16 + tq;
                bf16x8 q[8]; load_q_mem(q, QMRAW + row * 512 + h * 128, hi, gq);
                f32x16 o[4]; float lsum;
                attn_block<128, 128>(ldc_, q, MK + (size_t)((l * 12 + 4 + b) * 4 + h) * 256 * 128, MVT + (size_t)((l * 12 + 4 + b) * 4 + h) * 128 * 256, 256, 4, wid == 0 ? 4 : 0, 256, o, lsum);
                attn_store<4>(o, lsum, OM + row * 512 + h * 128, hi, wid == 0 && r32 < 16);
            }
        }

        if (ph + 1 < P.ph_hi) { if (P.ph_hi > NPHASE) grid.sync(); else xcd_barrier(bar); }
#if REPEAT_SP
        if ((REPEAT_SP == 100 ? sp == 0 : sp == REPEAT_SP) && !redone) { redone = 1; --ph; } else redone = 0;
#endif
#if DOUBLE_SYNC
        if (ph + 1 < P.ph_hi) xcd_barrier(bar);
#endif
    }
}

#ifndef MULTI_LAUNCH
#define MULTI_LAUNCH 0
#endif
extern "C" void kernel_launch(void* const* d_in, const int* in_sizes, int n_in, void* d_out, int out_size, void* d_ws, size_t ws_size, hipStream_t stream) {
    static int grid = 0;
    if (grid == 0) {
        if (n_in != 37 || out_size != (int)O_END || ws_size < WS_END) { fprintf(stderr, "kernel_launch: unexpected shapes n_in %d out %d ws %zu (need %zu)\n", n_in, out_size, ws_size, (size_t)WS_END); grid = -1; return; }
        int dev = 0, cus = 0, per_cu = 0;
        hipGetDevice(&dev); hipDeviceGetAttribute(&cus, hipDeviceAttributeMultiprocessorCount, dev);
        hipFuncSetAttribute((const void*)fwd_kernel, hipFuncAttributeMaxDynamicSharedMemorySize, LDS_BYTES);
        hipOccupancyMaxActiveBlocksPerMultiprocessor(&per_cu, (const void*)fwd_kernel, 512, LDS_BYTES);
        if (per_cu < 1) per_cu = 1;
        (void)hipGetLastError();
        grid = cus * per_cu;
        if (grid > 256) grid = 256;
    }
    if (grid < 0) return;
    if (hipMemsetAsync((char*)d_ws + OFF_CTL, 0, CTL_BYTES, stream) != hipSuccess) { fprintf(stderr, "kernel_launch: memset failed\n"); return; }
    Params p{};
    for (int i = 0; i < 37; ++i) p.in[i] = (const float*)d_in[i];
    p.out = (float*)d_out; p.ws = (unsigned char*)d_ws;
#if MULTI_LAUNCH
    for (int ph = 0; ph < NPHASE; ++ph) { p.ph_lo = ph; p.ph_hi = ph + 1; hipLaunchKernelGGL(fwd_kernel, dim3(grid), dim3(512), LDS_BYTES, stream, p); }
#else
    p.ph_lo = 0; p.ph_hi = NPHASE;
    void* args[] = {&p};
    hipError_t e = hipLaunchCooperativeKernel((const void*)fwd_kernel, dim3(grid), dim3(512), args, LDS_BYTES, stream);
    if (e != hipSuccess) fprintf(stderr, "cooperative launch failed: %s (grid %d)\n", hipGetErrorString(e), grid);
#endif
}
```

```cpp
#include <hip/hip_runtime.h>
#include <hip/hip_cooperative_groups.h>
#include <cstdio>
#include <cstdint>
namespace cg = cooperative_groups;
namespace pg8 {
#define PG8_LAS __attribute__((address_space(3)))
typedef unsigned short bf16_t;
typedef short bf16x8 __attribute__((ext_vector_type(8)));
typedef float f32x4 __attribute__((ext_vector_type(4)));
typedef unsigned u32x4 __attribute__((ext_vector_type(4)));
constexpr int BM = 256, BK = 64, HALF = 128, HTB = HALF * BK * 2  , STAGE_BYTES = 8 * HTB, NXCD = 8, WGM = 8;

__host__ __device__ __forceinline__ int lds_byte(int r, int c) { const int st = (r >> 4) * 2 + (c >> 5), rr = r & 15, cc = c & 31, ob = rr * 64 + cc * 2; return st * 1024 + (ob ^ (((ob >> 9) & 1) << 5)); }
__host__ __device__ __forceinline__ void stage_rc(int b, int& R, int& C) { const int st = b / 1024, sb = b % 1024, swz = sb ^ (((sb >> 9) & 1) << 5); R = (st >> 1) * 16 + swz / 64; C = (st & 1) * 32 + (swz % 64) / 2; }
__host__ __device__ __forceinline__ int perm32(int rho) { const int n = rho >> 4, i = rho & 15; return 8 * (i >> 2) + 4 * n + (i & 3); }

struct Unit { int pm, pn; };
struct Gemm { const bf16_t* A; const bf16_t* Bt; int M, N, K; };

struct StaticOrder {
    int nM, nN, nwg, G, c;
    __host__ __device__ void init(int M, int N, int G_, int c_) { nM = M / BM; nN = N / BM; nwg = nM * nN; G = G_; c = c_; }
    __host__ __device__ bool next(int i, Unit& u) const {
        const long L = (long)i * G + c; if (L >= nwg) return false;
        int wgid = (int)L; { const int q = nwg / NXCD, r = nwg % NXCD, xcd = wgid % NXCD, off = wgid / NXCD; wgid = (xcd < r ? xcd * (q + 1) : r * (q + 1) + (xcd - r) * q) + off; }
        const int nig = WGM * nN, gid = wgid / nig, fm = gid * WGM, gsz = (nM - fm) < WGM ? (nM - fm) : WGM;
        u.pm = fm + ((wgid % nig) % gsz); u.pn = (wgid % nig) / gsz; return true;
    }
    __device__ __forceinline__ void a_ready(const Unit&) const {}
    __device__ __forceinline__ void done(const Unit&) const {}
};

__device__ __forceinline__ unsigned cvt_pk_bf16(float lo, float hi) { unsigned r; asm volatile("v_cvt_pk_bf16_f32 %0, %1, %2" : "=v"(r) : "v"(lo), "v"(hi)); return r; }
typedef float f32x2 __attribute__((ext_vector_type(2)));
__device__ __forceinline__ f32x2 gelu_pk(f32x2 v) {
    const f32x2 av = __builtin_elementwise_abs(v), d = av * 0.2316418882f + 1.0f;
    f32x2 t; t.x = __builtin_amdgcn_rcpf(d.x); t.y = __builtin_amdgcn_rcpf(d.y);
    f32x2 q = t * 0.5307027145f + (-0.7265760135f); q = q * t + 0.7107068705f; q = q * t + (-0.142248368f); q = q * t + 0.127414796f; q = q * t;
    const f32x2 s = (v * v) * (-0.72134752044f);
    f32x2 e; e.x = __builtin_amdgcn_exp2f(s.x); e.y = __builtin_amdgcn_exp2f(s.y);
    const f32x2 m = v * (q * e), r = v - m;
    f32x2 o; o.x = v.x < 0.f ? m.x : r.x; o.y = v.y < 0.f ? m.y : r.y; return o;
}

template <class Epi, class Sched, bool ALIGN_EPI = false, bool SP2 = false>
__device__ __forceinline__ void gemm_phase(PG8_LAS unsigned char* lds, const Gemm g, const Sched& S, const Epi& E) {
    int tid = threadIdx.x; asm volatile("" : "+v"(tid));
    const int wid = __builtin_amdgcn_readfirstlane(tid >> 6), lane = tid & 63, wr = wid >> 2, wc = wid & 3, fr = lane & 15, fq = lane >> 4;
    const int K = g.K, nt = K / BK;
    unsigned voffA[2], voffB[2];
#pragma unroll
    for (int i = 0; i < 2; ++i) { int R, C; stage_rc(tid * 16 + i * 8192, R, C); const int Rb = Epi::PERM ? ((R & ~31) + perm32(R & 31)) : R;
        voffA[i] = (unsigned)(R * K + C) * 2u; voffB[i] = (unsigned)(Rb * K + C) * 2u; }
    const size_t kstep = (size_t)(BK * 2);
    const size_t hstep = (size_t)HALF * K * 2;
    const size_t tstep = 2 * hstep;
    const unsigned ldsw = (unsigned)wid * 1024u;
    const int aoff = lds_byte(wr * 64 + fr, fq * 8), boff = lds_byte(wc * 32 + fr, fq * 8);
#define PG8_SA(b, h) (((b) * 2 + (h)) * HTB)
#define PG8_SB(b, h) ((4 + (b) * 2 + (h)) * HTB)
#define PG8_STAGE(bufoff, gbase, voff) do { _Pragma("unroll") for (int _i = 0; _i < 2; ++_i) \
        __builtin_amdgcn_global_load_lds((const unsigned*)((const char*)(gbase) + (voff)[_i]), (PG8_LAS unsigned*)(lds + (bufoff) + ldsw + _i * 8192), 16, 0, 0); } while (0)
#define PG8_LDA(dst, b, h) do { _Pragma("unroll") for (int m = 0; m < 4; ++m) _Pragma("unroll") for (int k = 0; k < 2; ++k) dst[m][k] = *(const PG8_LAS bf16x8*)(lds + PG8_SA(b, h) + aoff + m * 2048 + k * 1024); } while (0)
#define PG8_LDB(dst, b, h) do { _Pragma("unroll") for (int n = 0; n < 2; ++n) _Pragma("unroll") for (int k = 0; k < 2; ++k) dst[n][k] = *(const PG8_LAS bf16x8*)(lds + PG8_SB(b, h) + boff + n * 2048 + k * 1024); } while (0)
#define PG8_MMA(ai, bj, At, Bt) do { __builtin_amdgcn_s_setprio(1); _Pragma("unroll") for (int m = 0; m < 4; ++m) _Pragma("unroll") for (int n = 0; n < 2; ++n) _Pragma("unroll") for (int k = 0; k < 2; ++k) \
        acc[ai][bj][m][n] = __builtin_amdgcn_mfma_f32_16x16x32_bf16(Bt[n][k], At[m][k], acc[ai][bj][m][n], 0, 0, 0); __builtin_amdgcn_s_setprio(0); } while (0)
#define PG8_WAIT_V(n) asm volatile("s_waitcnt vmcnt(" #n ")" ::: "memory")
#define PG8_WAIT_L(n) asm volatile("s_waitcnt lgkmcnt(" #n ")" ::: "memory")
#define PG8_BAR __builtin_amdgcn_s_barrier()
#define PG8_SCHED __builtin_amdgcn_sched_barrier(0)
    Unit cur, nxt; int ui = 0;
    if (!S.next(0, cur)) return;
    f32x4 acc[2][2][4][2];
#pragma unroll
    for (int a = 0; a < 2; ++a)
#pragma unroll
        for (int b = 0; b < 2; ++b)
#pragma unroll
            for (int m = 0; m < 4; ++m)
#pragma unroll
                for (int n = 0; n < 2; ++n) acc[a][b][m][n] = (f32x4){0.f, 0.f, 0.f, 0.f};
    bf16x8 At[4][2], B0[2][2], B1[2][2];
    const char* cA = (const char*)g.A + (size_t)cur.pm * tstep; const char* cB = (const char*)g.Bt + (size_t)cur.pn * tstep;
    S.a_ready(cur);
    if constexpr (SP2) {
        PG8_STAGE(PG8_SB(0, 0), cB, voffB); PG8_STAGE(PG8_SB(0, 1), cB + hstep, voffB); PG8_STAGE(PG8_SA(0, 0), cA, voffA); PG8_STAGE(PG8_SA(0, 1), cA + hstep, voffA);
        if (wr == 1) PG8_BAR;
        PG8_WAIT_V(2); PG8_BAR;
        PG8_STAGE(PG8_SB(1, 0), cB + kstep, voffB); PG8_STAGE(PG8_SA(1, 0), cA + kstep, voffA); PG8_STAGE(PG8_SB(1, 1), cB + hstep + kstep, voffB);
        PG8_WAIT_V(6); PG8_BAR;
    } else {
        PG8_STAGE(PG8_SB(0, 0), cB, voffB); PG8_STAGE(PG8_SA(0, 0), cA, voffA); PG8_STAGE(PG8_SB(0, 1), cB + hstep, voffB); PG8_STAGE(PG8_SA(0, 1), cA + hstep, voffA);
        if (wr == 1) PG8_BAR;
        PG8_WAIT_V(4); PG8_BAR;
        PG8_STAGE(PG8_SB(1, 0), cB + kstep, voffB); PG8_STAGE(PG8_SA(1, 0), cA + kstep, voffA); PG8_STAGE(PG8_SB(1, 1), cB + hstep + kstep, voffB);
        PG8_WAIT_V(6); PG8_BAR;
    }
    for (;;) {
        const bool has_next = S.next(ui + 1, nxt);
        const char* nA = has_next ? (const char*)g.A + (size_t)nxt.pm * tstep : cA; const char* nB = has_next ? (const char*)g.Bt + (size_t)nxt.pn * tstep : cB;
        for (int t = 0; t < nt; t += 2) {
            const bool last = (t == nt - 2);
            const char* a1 = cA + (size_t)(t + 1) * kstep;
            const char* a2 = last ? nA : cA + (size_t)(t + 2) * kstep; const char* b2 = last ? nB : cB + (size_t)(t + 2) * kstep;
            const char* a3 = a2 + kstep; const char* b3 = b2 + kstep;
            if (last && has_next) S.a_ready(nxt);
            if constexpr (SP2) {
            PG8_LDB(B0, 0, 0); PG8_LDB(B1, 0, 1); PG8_SCHED; PG8_LDA(At, 0, 0); PG8_STAGE(PG8_SA(1, 1), a1 + hstep, voffA);
            PG8_WAIT_V(8); PG8_WAIT_L(0); PG8_BAR; PG8_MMA(0, 0, At, B0); PG8_MMA(0, 1, At, B1); PG8_BAR; PG8_SCHED;
            PG8_LDA(At, 0, 1); PG8_STAGE(PG8_SB(0, 0), b2, voffB); PG8_STAGE(PG8_SB(0, 1), b2 + hstep, voffB); PG8_STAGE(PG8_SA(0, 0), a2, voffA);
            PG8_WAIT_V(8); PG8_WAIT_L(0); PG8_BAR; PG8_MMA(1, 0, At, B0); PG8_MMA(1, 1, At, B1); PG8_BAR; PG8_SCHED;
            PG8_LDB(B0, 1, 0); PG8_LDB(B1, 1, 1); PG8_SCHED; PG8_LDA(At, 1, 0); PG8_STAGE(PG8_SA(0, 1), a2 + hstep, voffA);
            PG8_WAIT_V(8); PG8_WAIT_L(0); PG8_BAR; PG8_MMA(0, 0, At, B0); PG8_MMA(0, 1, At, B1); PG8_BAR; PG8_SCHED;
            PG8_LDA(At, 1, 1); PG8_STAGE(PG8_SB(1, 0), b3, voffB); PG8_STAGE(PG8_SB(1, 1), b3 + hstep, voffB); PG8_STAGE(PG8_SA(1, 0), a3, voffA);
            PG8_WAIT_V(8); PG8_WAIT_L(0); PG8_BAR; PG8_MMA(1, 0, At, B0); PG8_MMA(1, 1, At, B1); PG8_BAR; PG8_SCHED;
            } else {
            PG8_LDB(B0, 0, 0); PG8_SCHED; PG8_LDA(At, 0, 0); PG8_STAGE(PG8_SA(1, 1), a1 + hstep, voffA);
            PG8_WAIT_L(8); PG8_BAR; PG8_WAIT_L(0); PG8_MMA(0, 0, At, B0); PG8_BAR; PG8_SCHED;
            PG8_LDB(B1, 0, 1); PG8_STAGE(PG8_SB(0, 0), b2, voffB);
            PG8_BAR; PG8_WAIT_L(0); PG8_MMA(0, 1, At, B1); PG8_BAR;
            PG8_LDA(At, 0, 1); PG8_STAGE(PG8_SA(0, 0), a2, voffA);
            PG8_BAR; PG8_WAIT_L(0); PG8_MMA(1, 0, At, B0); PG8_BAR; PG8_SCHED;
            PG8_STAGE(PG8_SB(0, 1), b2 + hstep, voffB);
            PG8_WAIT_V(6); PG8_BAR; PG8_MMA(1, 1, At, B1); PG8_BAR;
            PG8_LDB(B0, 1, 0); PG8_SCHED; PG8_LDA(At, 1, 0); PG8_STAGE(PG8_SA(0, 1), a2 + hstep, voffA);
            PG8_WAIT_L(8); PG8_BAR; PG8_WAIT_L(0); PG8_MMA(0, 0, At, B0); PG8_BAR; PG8_SCHED;
            PG8_LDB(B1, 1, 1); PG8_STAGE(PG8_SB(1, 0), b3, voffB);
            PG8_BAR; PG8_WAIT_L(0); PG8_MMA(0, 1, At, B1); PG8_BAR;
            PG8_LDA(At, 1, 1); PG8_STAGE(PG8_SA(1, 0), a3, voffA);
            PG8_BAR; PG8_WAIT_L(0); PG8_MMA(1, 0, At, B0); PG8_BAR; PG8_SCHED;
            PG8_STAGE(PG8_SB(1, 1), b3 + hstep, voffB);
            PG8_WAIT_V(6); PG8_BAR; PG8_MMA(1, 1, At, B1); PG8_BAR;
            }
        }
        if constexpr (ALIGN_EPI) { if (wr == 0) PG8_BAR; }
        if constexpr (!Epi::AFTER_DRAIN) { E(acc, cur, wr, wc, fr, fq); S.done(cur); }
        if (!has_next) break;
#pragma unroll
        for (int a = 0; a < 2; ++a)
#pragma unroll
            for (int b = 0; b < 2; ++b)
#pragma unroll
                for (int m = 0; m < 4; ++m)
#pragma unroll
                    for (int n = 0; n < 2; ++n) acc[a][b][m][n] = (f32x4){0.f, 0.f, 0.f, 0.f};
        cur = nxt; cA = nA; cB = nB; ++ui;
        if constexpr (ALIGN_EPI) { if (wr == 1) PG8_BAR; }
    }
    PG8_WAIT_V(0);
    if constexpr (!ALIGN_EPI) { if (wr == 0) PG8_BAR; }
    PG8_BAR;
    if constexpr (Epi::AFTER_DRAIN) { E.fused(acc, cur, wr, wc, fr, fq, lds, wid, lane); S.done(cur); }
#undef PG8_SA
#undef PG8_SB
#undef PG8_STAGE
#undef PG8_LDA
#undef PG8_LDB
#undef PG8_MMA
#undef PG8_WAIT_V
#undef PG8_WAIT_L
#undef PG8_BAR
#undef PG8_SCHED
}
}

#define LAS __attribute__((address_space(3)))
typedef unsigned short bf16;
typedef unsigned u32x4 __attribute__((ext_vector_type(4)));
typedef unsigned u32x2 __attribute__((ext_vector_type(2)));
typedef float f32x4 __attribute__((ext_vector_type(4)));
typedef float f32x16 __attribute__((ext_vector_type(16)));
typedef short bf16x8 __attribute__((ext_vector_type(8)));

constexpr int TP = 32768, TV = 32896, TT = 33024;
constexpr int LR = 41216, LRV = 41088;
constexpr int SKV = 1040, KHS_T = 1104;
constexpr float EPS = 1e-6f;
constexpr float LOG2E = 1.4426950408889634f;
constexpr float SC_MLA = 0.10206207261596577f * LOG2E;
constexpr float SC_MEM = 0.08838834764831845f * LOG2E;

constexpr size_t al256(size_t x) { return (x + 255) & ~(size_t)255; }
constexpr size_t OFF_CTL = 0, CTL_BYTES = 16384;
constexpr size_t OFF_SS = CTL_BYTES;
constexpr size_t OFF_MSS = al256(OFF_SS + (size_t)6 * TT * 4);
constexpr size_t OFF_ROPE = al256(OFF_MSS + 1024 * 4);
constexpr size_t W_WIN = 0, W_WUQ = W_WIN + (size_t)1536 * 1024 * 2, W_WK = W_WUQ + (size_t)768 * 256 * 2, W_WVT = W_WK + (size_t)512 * 128 * 2,
                 W_WOUT = W_WVT + (size_t)512 * 128 * 2, W_WMQ = W_WOUT + (size_t)1024 * 1024 * 2, W_WMO = W_WMQ + (size_t)512 * 1024 * 2,
                 W_FF1 = W_WMO + (size_t)1024 * 512 * 2, W_FF2 = W_FF1 + (size_t)4096 * 1024 * 2, W_LAYER = W_FF2 + (size_t)1024 * 4096 * 2;
constexpr size_t OFF_W = al256(OFF_ROPE + (size_t)8192 * 16 * 8);
constexpr size_t OFF_WMKV = OFF_W + 2 * W_LAYER;
constexpr size_t OFF_MEMB = OFF_WMKV + (size_t)2048 * 1024 * 2;
constexpr size_t OFF_MKVRAW = OFF_MEMB + (size_t)1024 * 1024 * 2;
constexpr size_t OFF_MK = OFF_MKVRAW + (size_t)1024 * 2048 * 4;
constexpr size_t OFF_MVT = OFF_MK + (size_t)2 * 12 * 4 * 256 * 128 * 2;
constexpr size_t OFF_XB = OFF_MVT + (size_t)2 * 12 * 4 * 256 * 128 * 2;
constexpr size_t OFF_LATC = OFF_XB + (size_t)TT * 1024 * 2;
constexpr size_t OFF_KR = OFF_LATC + (size_t)LR * 128 * 2;
constexpr size_t OFF_UG = OFF_KR + (size_t)LR * 32 * 2;
constexpr size_t OFF_VG = OFF_UG + (size_t)TT * 256 * 2, OFF_Z = OFF_VG + (size_t)TT * 256 * 2, OFF_CQ = OFF_Z + (size_t)TT * 256 * 2;
constexpr size_t OFF_A = OFF_CQ + (size_t)TT * 256 * 2;
constexpr size_t SZ_A = (size_t)TT * 1536 * 2;
constexpr size_t OFF_H = OFF_A, OFF_QRAW = OFF_A, OFF_KRAW = OFF_A + (size_t)TT * 768 * 2, OFF_QMRAW = OFF_A, OFF_OM = OFF_A + (size_t)TT * 512 * 2;
static_assert((size_t)TT * 768 * 2 + (size_t)LR * 512 * 2 <= SZ_A, "region A");
constexpr size_t OFF_B = OFF_A + SZ_A;
constexpr size_t OFF_VT = OFF_B, OFF_KH = OFF_VT + (size_t)512 * LR * 2, OFF_KHS = OFF_KH + (size_t)32 * 8192 * 96 * 2;
constexpr size_t OFF_C = OFF_KHS + (size_t)64 * KHS_T * 96 * 2;
constexpr size_t OFF_MIX = OFF_C;
constexpr size_t OFF_HID = OFF_A;
constexpr size_t WS_END = OFF_MIX + (size_t)TT * 1024 * 2;
static_assert(OFF_HID + (size_t)TT * 4096 * 2 <= WS_END, "HID overlay");

constexpr size_t O_YP = 0, O_YS = 33554432, O_LATP = 33685504, O_KRP = 42074112, O_CONVP = 44171264, O_MKP = 44232704, O_MVP = 45281280,
                 O_LATS = 46329856, O_KRS = 46362624, O_CONVS = 46370816, O_GVS = 46493696, O_END = 46559232;

constexpr int LDS_BYTES = 147456;
constexpr int NPHASE = 23;

struct Params { const float* in[37]; float* out; unsigned char* ws; int ph_lo, ph_hi; };

__device__ __forceinline__ float bflo(unsigned w) { return __uint_as_float(w << 16); }
__device__ __forceinline__ float bfhi(unsigned w) { return __uint_as_float(w & 0xffff0000u); }
__device__ __forceinline__ unsigned pk2(float lo, float hi) {
    typedef float f2_t __attribute__((ext_vector_type(2))); typedef __bf16 b2_t __attribute__((ext_vector_type(2)));
    f2_t v = {lo, hi}; b2_t b = __builtin_convertvector(v, b2_t); return __builtin_bit_cast(unsigned, b);
}
template <int CTRL> __device__ __forceinline__ float dpp_add(float v) {
    return v + __builtin_bit_cast(float, __builtin_amdgcn_update_dpp(0, __builtin_bit_cast(int, v), CTRL, 0xf, 0xf, true));
}
__device__ __forceinline__ float sum4(float v) { v = dpp_add<0xB1>(v); return dpp_add<0x4E>(v); }
__device__ __forceinline__ float sum8(float v) { return dpp_add<0x141>(sum4(v)); }
__device__ __forceinline__ float sum16(float v) { return dpp_add<0x140>(sum8(v)); }
__device__ __forceinline__ float swap16_sum(float v) {
    auto rr = __builtin_amdgcn_permlane16_swap(__float_as_uint(v), __float_as_uint(v), false, false);
    return __uint_as_float(rr[0]) + __uint_as_float(rr[1]);
}
__device__ __forceinline__ float half_sum(float v);
__device__ __forceinline__ float wave_sum(float v) { return half_sum(swap16_sum(sum16(v))); }
__device__ __forceinline__ float half_sum(float v) {
    auto rr = __builtin_amdgcn_permlane32_swap(__float_as_uint(v), __float_as_uint(v), false, false);
    return __uint_as_float(rr[0]) + __uint_as_float(rr[1]);
}
__device__ __forceinline__ float half_max(float v) {
    auto rr = __builtin_amdgcn_permlane32_swap(__float_as_uint(v), __float_as_uint(v), false, false);
    return fmaxf(__uint_as_float(rr[0]), __uint_as_float(rr[1]));
}
__device__ __forceinline__ float gelu_f(float x) { return 0.5f * x * (1.0f + erff(x * 0.70710678118654752f)); }
__device__ __forceinline__ float sigm_f(float x) { return 1.0f / (1.0f + __expf(-x)); }

struct EpiU {
    static constexpr bool PERM = false, AFTER_DRAIN = false;
    int mode;
    int relu2;
    void* out; int ldc;
    const float* ss; float ssdiv;
    float* ssout;
    const float* base_p; const float* base_s; bf16* xb;
    const float* gkn; const bf16* kr; bf16* kh; bf16* khs;
    __device__ __forceinline__ void operator()(const pg8::f32x4 (&acc)[2][2][4][2], const pg8::Unit& u, int wr, int wc, int fr, int fq) const {
        const int row0 = u.pm * 256 + wr * 64 + fr, col0 = u.pn * 256 + wc * 32 + 4 * fq;
#pragma unroll
        for (int ai = 0; ai < 2; ++ai)
#pragma unroll
            for (int m = 0; m < 4; ++m) {
                const int row = row0 + ai * 128 + m * 16;
                const float rs = ss ? rsqrtf(ss[row] * ssdiv + EPS) : 1.0f;
#pragma unroll
                for (int bj = 0; bj < 2; ++bj)
#pragma unroll
                    for (int n = 0; n < 2; ++n) { const int c = col0 + bj * 128 + n * 16; *(f32x4*)((float*)out + (size_t)row * ldc + c) = acc[ai][bj][m][n] * rs; }
            }
    }
};

struct EpiP {
    static constexpr bool PERM = true, AFTER_DRAIN = false;
    int mode;
    int relu2; void* out; int ldc; const float* ss; float ssdiv; float* ssout; bf16* xb;
    const float* gkn; const bf16* kr; bf16* kh; bf16* khs;
    __device__ __forceinline__ void operator()(const pg8::f32x4 (&acc)[2][2][4][2], const pg8::Unit& u, int wr, int wc, int fr, int fq) const {
        const int row0 = u.pm * 256 + wr * 64 + fr, col0 = u.pn * 256 + wc * 32 + 8 * fq;
        if (mode == 0) {
            float rsv[2][4];
#pragma unroll
            for (int ai = 0; ai < 2; ++ai)
#pragma unroll
                for (int m = 0; m < 4; ++m) rsv[ai][m] = ss ? ss[row0 + ai * 128 + m * 16] : 0.f;
#pragma unroll
            for (int ai = 0; ai < 2; ++ai)
#pragma unroll
                for (int m = 0; m < 4; ++m) {
                    const int row = row0 + ai * 128 + m * 16;
                    const float rs = ss ? rsqrtf(rsv[ai][m] * ssdiv + EPS) : 1.0f;
                    bf16* rowp = (bf16*)out + (size_t)row * ldc + col0;
#pragma unroll
                    for (int bj = 0; bj < 2; ++bj) { f32x4 v0 = acc[ai][bj][m][0] * rs, v1 = acc[ai][bj][m][1] * rs;
                        if (relu2) { v0[0] = fmaxf(v0[0], 0.f); v0[1] = fmaxf(v0[1], 0.f); v0[2] = fmaxf(v0[2], 0.f); v0[3] = fmaxf(v0[3], 0.f); v0 = v0 * v0;
                                     v1[0] = fmaxf(v1[0], 0.f); v1[1] = fmaxf(v1[1], 0.f); v1[2] = fmaxf(v1[2], 0.f); v1[3] = fmaxf(v1[3], 0.f); v1 = v1 * v1; }
                        u32x4 w; w.x = pk2(v0[0], v0[1]); w.y = pk2(v0[2], v0[3]); w.z = pk2(v1[0], v1[1]); w.w = pk2(v1[2], v1[3]);
                        *(u32x4*)(rowp + bj * 128) = w; }
                }
        } else if (mode == 1) {
#pragma unroll
            for (int ai = 0; ai < 2; ++ai) {
                u32x4 bwv[4][2];
#pragma unroll
                for (int m = 0; m < 4; ++m)
#pragma unroll
                    for (int bj = 0; bj < 2; ++bj) bwv[m][bj] = *(const u32x4*)(xb + (size_t)(row0 + ai * 128 + m * 16) * 1024 + col0 + bj * 128);
#pragma unroll
                for (int m = 0; m < 4; ++m) {
                    const int row = row0 + ai * 128 + m * 16; float s2 = 0.f;
                    bf16* xp = xb + (size_t)row * 1024 + col0; float* op = (float*)out + (size_t)row * 1024 + col0;
#pragma unroll
                    for (int bj = 0; bj < 2; ++bj) { const u32x4 bw = bwv[m][bj];
                        const f32x4 x0 = (f32x4){bflo(bw.x), bfhi(bw.x), bflo(bw.y), bfhi(bw.y)} + acc[ai][bj][m][0], x1 = (f32x4){bflo(bw.z), bfhi(bw.z), bflo(bw.w), bfhi(bw.w)} + acc[ai][bj][m][1];
                        if (out) { *(f32x4*)(op + bj * 128) = x0; *(f32x4*)(op + bj * 128 + 4) = x1; }
                        else { u32x4 w; w.x = pk2(x0[0], x0[1]); w.y = pk2(x0[2], x0[3]); w.z = pk2(x1[0], x1[1]); w.w = pk2(x1[2], x1[3]); *(u32x4*)(xp + bj * 128) = w; }
                        s2 += ((x0[0] * x0[0] + x0[1] * x0[1]) + (x0[2] * x0[2] + x0[3] * x0[3])) + ((x1[0] * x1[0] + x1[1] * x1[1]) + (x1[2] * x1[2] + x1[3] * x1[3])); }
                    s2 = half_sum(swap16_sum(s2));
                    if (fq == 0) unsafeAtomicAdd(ssout + row, s2);
                }
            }
        } else {
            const int hh = 4 * u.pn + wc;
            f32x4 gv[2][2];
#pragma unroll
            for (int bj = 0; bj < 2; ++bj)
#pragma unroll
                for (int n = 0; n < 2; ++n) gv[bj][n] = *(const f32x4*)(gkn + 32 * bj + 8 * fq + 4 * n);
            u32x4 krv[2][4];
#pragma unroll
            for (int ai = 0; ai < 2; ++ai)
#pragma unroll
                for (int m = 0; m < 4; ++m) { const int r = row0 + ai * 128 + m * 16; krv[ai][m] = *(const u32x4*)(kr + (size_t)(r < LRV ? r : 0) * 32 + 8 * fq); }
#pragma unroll
            for (int ai = 0; ai < 2; ++ai)
#pragma unroll
                for (int m = 0; m < 4; ++m) {
                    const int r = row0 + ai * 128 + m * 16; float s2 = 0.f;
#pragma unroll
                    for (int bj = 0; bj < 2; ++bj)
#pragma unroll
                        for (int n = 0; n < 2; ++n) { const f32x4 x = acc[ai][bj][m][n]; s2 += (x[0] * x[0] + x[1] * x[1]) + (x[2] * x[2] + x[3] * x[3]); }
                    s2 = half_sum(swap16_sum(s2));
                    const float rs = rsqrtf(s2 * (1.0f / 64.0f) + EPS);
                    if (r < LRV) {
                        bf16* dst;
                        if (r < TP) { const int b = r >> 13, t = r & 8191; dst = kh + ((size_t)(b * 8 + hh) * 8192 + t) * 96; }
                        else { const int rr = r - TP, b = rr / SKV, t = rr - b * SKV; dst = khs + ((size_t)(b * 8 + hh) * KHS_T + t) * 96; }
#pragma unroll
                        for (int bj = 0; bj < 2; ++bj) { const f32x4 v0 = acc[ai][bj][m][0] * rs * gv[bj][0], v1 = acc[ai][bj][m][1] * rs * gv[bj][1];
                            u32x4 w; w.x = pk2(v0[0], v0[1]); w.y = pk2(v0[2], v0[3]); w.z = pk2(v1[0], v1[1]); w.w = pk2(v1[2], v1[3]);
                            *(u32x4*)(dst + 32 * bj + 8 * fq) = w; }
                        *(u32x4*)(dst + 64 + 8 * fq) = krv[ai][m];
                    }
                }
        }
    }
};

#define MFMA32(a, b, c) __builtin_amdgcn_mfma_f32_32x32x16_bf16((a), (b), (c), 0, 0, 0)
template <int KSTR, int VSTR> struct SrcLds {
    const LAS char* k; const LAS char* v;
    __device__ __forceinline__ bf16x8 kfrag(int hf, int s) const { return *(const LAS bf16x8*)(k + hf * 32 * KSTR + s * 32); }
    __device__ __forceinline__ bf16x8 vfrag(int dd, int hf, int s2) const { return *(const LAS bf16x8*)(v + dd * 32 * VSTR + hf * 64 + s2 * 32); }
};
#define MX3(a, b, c) __builtin_fmaxf(__builtin_fmaxf((a), (b)), (c))
template <int NS, int ND, class Src>
__device__ __forceinline__ void attn_tile(const bf16x8 (&q)[NS], f32x16 (&o)[ND], bool& shifted, float& m, float& l, const Src& src, int kvalid, int hi) {
    f32x16 z;
#pragma unroll
    for (int r = 0; r < 16; ++r) z[r] = 0.f;
    constexpr bool BATCH = (NS == 6);
    f32x16 p0, p1; bf16x8 vfa[ND][2];
    if constexpr (BATCH) {
        bf16x8 k0[NS], k1[NS];
#pragma unroll
        for (int s = 0; s < NS; ++s) { k0[s] = src.kfrag(0, s); k1[s] = src.kfrag(1, s); }
        __builtin_amdgcn_sched_barrier(0);
        p0 = MFMA32(k0[0], q[0], z); p1 = MFMA32(k1[0], q[0], z);
#pragma unroll
        for (int s = 1; s < NS; ++s) { p0 = MFMA32(k0[s], q[s], p0); p1 = MFMA32(k1[s], q[s], p1); }
#pragma unroll
        for (int dd = 0; dd < ND; ++dd) { vfa[dd][0] = src.vfrag(dd, 0, 0); vfa[dd][1] = src.vfrag(dd, 0, 1); }
        __builtin_amdgcn_sched_barrier(0);
    } else {
        p0 = MFMA32(src.kfrag(0, 0), q[0], z); p1 = MFMA32(src.kfrag(1, 0), q[0], z);
#pragma unroll
        for (int s = 1; s < NS; ++s) { p0 = MFMA32(src.kfrag(0, s), q[s], p0); p1 = MFMA32(src.kfrag(1, s), q[s], p1); }
    }
    if (kvalid < 64) {
#pragma unroll
        for (int r = 0; r < 16; ++r) { const int kv = 16 * (r >> 3) + 8 * hi + (r & 7); if (kv >= kvalid) p0[r] = -INFINITY; if (kv + 32 >= kvalid) p1[r] = -INFINITY; }
    }
    float ma = MX3(p0[0], p0[1], p1[0]), mb = MX3(p0[2], p0[3], p1[1]); ma = MX3(ma, p1[2], p1[3]);
#pragma unroll
    for (int r = 4; r < 16; r += 4) { ma = MX3(ma, p0[r], p0[r + 1]); mb = MX3(mb, p0[r + 2], p0[r + 3]); ma = MX3(ma, p1[r], p1[r + 1]); mb = MX3(mb, p1[r + 2], p1[r + 3]); }
    const float mx = half_max(fmaxf(ma, mb)) - m;
    if (__any(fabsf(mx) > 8.0f)) {
        const float dl = fabsf(mx) > 8.0f ? mx : 0.0f; m += dl;
        const float f = __builtin_amdgcn_exp2f(-dl); l *= f;
#pragma unroll
        for (int dd = 0; dd < ND; ++dd) o[dd] = o[dd] * f;
        shifted = __any(m != 0.0f);
    }
    if (shifted) {
#pragma unroll
        for (int r = 0; r < 16; ++r) { p0[r] -= m; p1[r] -= m; }
    }
    float sum = 0.f; bf16x8 pb0, pb1;
#pragma unroll
    for (int r = 0; r < 16; ++r) { p0[r] = __builtin_amdgcn_exp2f(p0[r]); sum += p0[r]; }
    { u32x4 w; w.x = pk2(p0[0], p0[1]); w.y = pk2(p0[2], p0[3]); w.z = pk2(p0[4], p0[5]); w.w = pk2(p0[6], p0[7]); pb0 = __builtin_bit_cast(bf16x8, w);
      w.x = pk2(p0[8], p0[9]); w.y = pk2(p0[10], p0[11]); w.z = pk2(p0[12], p0[13]); w.w = pk2(p0[14], p0[15]); pb1 = __builtin_bit_cast(bf16x8, w); }
    bf16x8 vfb[ND][2];
    if constexpr (BATCH) {
#pragma unroll
        for (int dd = 0; dd < ND; ++dd) { vfb[dd][0] = src.vfrag(dd, 1, 0); vfb[dd][1] = src.vfrag(dd, 1, 1); }
        __builtin_amdgcn_sched_barrier(0);
#pragma unroll
        for (int dd = 0; dd < ND; ++dd) { o[dd] = MFMA32(vfa[dd][0], pb0, o[dd]); o[dd] = MFMA32(vfa[dd][1], pb1, o[dd]); }
    } else {
#pragma unroll
        for (int dd = 0; dd < ND; ++dd) { o[dd] = MFMA32(src.vfrag(dd, 0, 0), pb0, o[dd]); o[dd] = MFMA32(src.vfrag(dd, 0, 1), pb1, o[dd]); }
    }
#pragma unroll
    for (int r = 0; r < 16; ++r) { p1[r] = __builtin_amdgcn_exp2f(p1[r]); sum += p1[r]; }
    { u32x4 w; w.x = pk2(p1[0], p1[1]); w.y = pk2(p1[2], p1[3]); w.z = pk2(p1[4], p1[5]); w.w = pk2(p1[6], p1[7]); pb0 = __builtin_bit_cast(bf16x8, w);
      w.x = pk2(p1[8], p1[9]); w.y = pk2(p1[10], p1[11]); w.z = pk2(p1[12], p1[13]); w.w = pk2(p1[14], p1[15]); pb1 = __builtin_bit_cast(bf16x8, w); }
#pragma unroll
    for (int dd = 0; dd < ND; ++dd) { if constexpr (BATCH) { o[dd] = MFMA32(vfb[dd][0], pb0, o[dd]); o[dd] = MFMA32(vfb[dd][1], pb1, o[dd]); }
                                      else { o[dd] = MFMA32(src.vfrag(dd, 1, 0), pb0, o[dd]); o[dd] = MFMA32(src.vfrag(dd, 1, 1), pb1, o[dd]); } }
    l += sum;
}

template <int DQK, int DV>
__device__ __forceinline__ void attn_block(LAS char* lds, const bf16x8 (&q)[DQK / 16], const bf16* Kg, const bf16* Vg, int vstride, int ntile, int mynt, int kvlen,
                                           f32x16 (&o)[DV / 32], float& lsum) {
    constexpr int NS = DQK / 16, ND = DV / 32, KSTR = DQK * 2 + 16, VSTR = 144, KB = 64 * KSTR, VB = DV * VSTR, BUF = KB + VB;
    constexpr int KCH = DQK / 8, NKC = 64 * KCH, NVI = DV / 64;
    int tid = threadIdx.x; asm volatile("" : "+v"(tid));
    const int lane = tid & 63, r32 = lane & 31, hi = lane >> 5;
    const int rowsw = (r32 & 0x13) | ((r32 & 4) << 1) | ((r32 & 8) >> 1);
    const int kc0 = tid, kc1 = tid + 512; const bool k1v = kc1 < NKC;
    typedef __attribute__((address_space(1))) const char gcc_t;
    gcc_t* Kgb = (gcc_t*)Kg; gcc_t* Vgb = (gcc_t*)Vg;
    const unsigned ko0 = (unsigned)((kc0 / KCH) * DQK + (kc0 % KCH) * 8) * 2u; const int kl0 = (kc0 / KCH) * KSTR + (kc0 % KCH) * 16;
    const unsigned ko1 = (unsigned)((kc1 / KCH) * DQK + (kc1 % KCH) * 8) * 2u; const int kl1 = (kc1 / KCH) * KSTR + (kc1 % KCH) * 16;
    unsigned vo[NVI]; int vl[NVI];
#pragma unroll
    for (int i = 0; i < NVI; ++i) { const int c = tid + 512 * i, d = c >> 3, vc = c & 7; vo[i] = (unsigned)(d * vstride + vc * 8) * 2u; vl[i] = KB + d * VSTR + vc * 16; }
    u32x4 kreg0, kreg1 = {0u, 0u, 0u, 0u}, vreg[NVI];
#define ATT_LOAD(t) do { gcc_t* kt_ = Kgb + (size_t)(t) * 64 * DQK * 2; gcc_t* vt_ = Vgb + (size_t)(t) * 128; \
        kreg0 = *(const __attribute__((address_space(1))) u32x4*)(kt_ + ko0); if (k1v) kreg1 = *(const __attribute__((address_space(1))) u32x4*)(kt_ + ko1); \
        _Pragma("unroll") for (int i_ = 0; i_ < NVI; ++i_) vreg[i_] = *(const __attribute__((address_space(1))) u32x4*)(vt_ + vo[i_]); } while (0)
#define ATT_STORE(bo) do { *(LAS u32x4*)(lds + (bo) + kl0) = kreg0; if (k1v) *(LAS u32x4*)(lds + (bo) + kl1) = kreg1; \
        _Pragma("unroll") for (int i_ = 0; i_ < NVI; ++i_) *(LAS u32x4*)(lds + (bo) + vl[i_]) = vreg[i_]; } while (0)
    ATT_LOAD(0); ATT_STORE(0); __syncthreads();
    float m = 0.f, l = 0.f; bool shifted = false;
#pragma unroll
    for (int dd = 0; dd < ND; ++dd)
#pragma unroll
        for (int r = 0; r < 16; ++r) o[dd][r] = 0.f;
    for (int t = 0; t < ntile; ++t) {
        const int cur = (t & 1) * BUF;
        if (t + 1 < ntile) ATT_LOAD(t + 1);
        if (t < mynt) { SrcLds<KSTR, VSTR> src{lds + cur + rowsw * KSTR + hi * 16, lds + cur + KB + r32 * VSTR + hi * 16}; attn_tile<NS, ND>(q, o, shifted, m, l, src, min(64, kvlen - 64 * t), hi); }
        if (t + 1 < ntile) ATT_STORE(((t + 1) & 1) * BUF);
        __syncthreads();
    }
#undef ATT_LOAD
#undef ATT_STORE
    lsum = half_sum(l);
}
template <int ND>
__device__ __forceinline__ void attn_store(const f32x16 (&o)[ND], float lsum, bf16* orow, int hi, bool valid) {
    const float inv = 1.0f / lsum;
    if (valid) {
#pragma unroll
        for (int dd = 0; dd < ND; ++dd)
#pragma unroll
            for (int rg = 0; rg < 4; ++rg) { u32x2 w; w.x = pk2(o[dd][4 * rg] * inv, o[dd][4 * rg + 1] * inv); w.y = pk2(o[dd][4 * rg + 2] * inv, o[dd][4 * rg + 3] * inv);
                *(u32x2*)(orow + 32 * dd + 8 * rg + 4 * hi) = w; }
    }
}
__device__ __forceinline__ void load_q_mla(bf16x8 (&q)[6], const bf16* qp  , int hi, const float* gqn, const float* gqr, const float* ropep  ) {
    u32x4 raw[6];
#pragma unroll
    for (int s = 0; s < 6; ++s) raw[s] = *(const u32x4*)(qp + 16 * s + 8 * hi);
    float x[6][8];
#pragma unroll
    for (int s = 0; s < 6; ++s) { x[s][0] = bflo(raw[s].x); x[s][1] = bfhi(raw[s].x); x[s][2] = bflo(raw[s].y); x[s][3] = bfhi(raw[s].y);
        x[s][4] = bflo(raw[s].z); x[s][5] = bfhi(raw[s].z); x[s][6] = bflo(raw[s].w); x[s][7] = bfhi(raw[s].w); }
    float ss = 0.f, sr = 0.f;
#pragma unroll
    for (int s = 0; s < 4; ++s)
#pragma unroll
        for (int j = 0; j < 8; ++j) ss += x[s][j] * x[s][j];
#pragma unroll
    for (int j = 0; j < 8; ++j) sr += x[4][j] * x[4][j] + x[5][j] * x[5][j];
    ss = half_sum(ss); sr = half_sum(sr);
    const float rs = rsqrtf(ss * (1.0f / 64.0f) + EPS) * SC_MLA, rr = rsqrtf(sr * (1.0f / 32.0f) + EPS);
#pragma unroll
    for (int s = 0; s < 4; ++s)
#pragma unroll
        for (int j = 0; j < 8; ++j) x[s][j] *= rs * gqn[16 * s + 8 * hi + j];
#pragma unroll
    for (int j = 0; j < 8; ++j) { const int i = 8 * hi + j; const float a1 = x[4][j] * rr * gqr[i], a2 = x[5][j] * rr * gqr[16 + i];
        const float c = ropep[2 * i], sn = ropep[2 * i + 1]; x[4][j] = (a1 * c - a2 * sn) * SC_MLA; x[5][j] = (a1 * sn + a2 * c) * SC_MLA; }
#pragma unroll
    for (int s = 0; s < 6; ++s) { u32x4 w; w.x = pk2(x[s][0], x[s][1]); w.y = pk2(x[s][2], x[s][3]); w.z = pk2(x[s][4], x[s][5]); w.w = pk2(x[s][6], x[s][7]); q[s] = __builtin_bit_cast(bf16x8, w); }
}
__device__ __forceinline__ void load_q_mem(bf16x8 (&q)[8], const bf16* qp  , int hi, const float* gq) {
    u32x4 raw[8];
#pragma unroll
    for (int s = 0; s < 8; ++s) raw[s] = *(const u32x4*)(qp + 16 * s + 8 * hi);
    float ss = 0.f;
#pragma unroll
    for (int s = 0; s < 8; ++s) { const float a0 = bflo(raw[s].x), a1 = bfhi(raw[s].x), a2 = bflo(raw[s].y), a3 = bfhi(raw[s].y), a4 = bflo(raw[s].z), a5 = bfhi(raw[s].z), a6 = bflo(raw[s].w), a7 = bfhi(raw[s].w);
        ss += (a0 * a0 + a1 * a1) + (a2 * a2 + a3 * a3) + (a4 * a4 + a5 * a5) + (a6 * a6 + a7 * a7); }
    ss = half_sum(ss);
    const float rs = rsqrtf(ss * (1.0f / 128.0f) + EPS) * SC_MEM;
#pragma unroll
    for (int s = 0; s < 8; ++s) { const float* g = gq + 16 * s + 8 * hi; u32x4 w;
        w.x = pk2(bflo(raw[s].x) * rs * g[0], bfhi(raw[s].x) * rs * g[1]); w.y = pk2(bflo(raw[s].y) * rs * g[2], bfhi(raw[s].y) * rs * g[3]);
        w.z = pk2(bflo(raw[s].z) * rs * g[4], bfhi(raw[s].z) * rs * g[5]); w.w = pk2(bflo(raw[s].w) * rs * g[6], bfhi(raw[s].w) * rs * g[7]);
        q[s] = __builtin_bit_cast(bf16x8, w); }
}

__device__ __forceinline__ void skinny_gemm(const bf16* A  , const bf16* Bt, int N, int K, const EpiU& E, int gw, int NGW, int lane) {
    const int nwu = N >> 1; const int fr = lane & 15, fq = lane >> 4;
#pragma unroll 1
    for (int wu = gw; wu < nwu; wu += NGW) {
        const int rb = wu & 7, cb = wu >> 3;
        const bf16* ap = A + (size_t)(16 * rb + fr) * K + 8 * fq; const bf16* bp = Bt + (size_t)(16 * cb + fr) * K + 8 * fq;
        pg8::f32x4 acc = {0.f, 0.f, 0.f, 0.f};
        if ((K & 511) == 0) {
#pragma unroll 1
            for (int k0 = 0; k0 < K; k0 += 512) {
                bf16x8 a[16], w[16];
#pragma unroll
                for (int i = 0; i < 16; ++i) { a[i] = *(const bf16x8*)(ap + k0 + 32 * i); w[i] = *(const bf16x8*)(bp + k0 + 32 * i); }
#pragma unroll
                for (int i = 0; i < 16; ++i) acc = __builtin_amdgcn_mfma_f32_16x16x32_bf16(w[i], a[i], acc, 0, 0, 0);
            }
        } else {
#pragma unroll 1
            for (int k0 = 0; k0 < K; k0 += 256) {
                bf16x8 a[8], w[8];
#pragma unroll
                for (int i = 0; i < 8; ++i) { a[i] = *(const bf16x8*)(ap + k0 + 32 * i); w[i] = *(const bf16x8*)(bp + k0 + 32 * i); }
#pragma unroll
                for (int i = 0; i < 8; ++i) acc = __builtin_amdgcn_mfma_f32_16x16x32_bf16(w[i], a[i], acc, 0, 0, 0);
            }
        }
        const int row = TP + 16 * rb + fr, col = 16 * cb + 4 * fq;
        if (E.mode == 1) {
            bf16* xp = E.xb + (size_t)row * 1024 + col; const u32x2 bw = *(const u32x2*)xp; const f32x4 bs = {bflo(bw.x), bfhi(bw.x), bflo(bw.y), bfhi(bw.y)}; const f32x4 x = bs + acc;
            if (E.out) *(f32x4*)((float*)E.out + (size_t)row * 1024 + col) = x; else { u32x2 wv; wv.x = pk2(x[0], x[1]); wv.y = pk2(x[2], x[3]); *(u32x2*)xp = wv; }
            float s2 = (x[0] * x[0] + x[1] * x[1]) + (x[2] * x[2] + x[3] * x[3]);
            s2 = half_sum(swap16_sum(s2));
            if (fq == 0) unsafeAtomicAdd(E.ssout + row, s2);
        } else {
            const float rs = E.ss ? rsqrtf(E.ss[row] * E.ssdiv + EPS) : 1.0f; f32x4 v = acc * rs;
            if (E.relu2) { v[0] = fmaxf(v[0], 0.f); v[1] = fmaxf(v[1], 0.f); v[2] = fmaxf(v[2], 0.f); v[3] = fmaxf(v[3], 0.f); v = v * v; }
            u32x2 wv; wv.x = pk2(v[0], v[1]); wv.y = pk2(v[2], v[3]); *(u32x2*)((bf16*)E.out + (size_t)row * E.ldc + col) = wv;
        }
    }
}

__device__ __forceinline__ void conv_w(const float* W, int Nsrc, int K, int ndst, int blk, int sblk, int soff, const float* gain, bf16* dst, LAS float* scr, int gw, int NGW, int lane) {
    const int nblk = ndst / 32, nitems = (K / 64) * nblk;
#pragma unroll 1
    for (int it = gw; it < nitems; it += NGW) {
        const int kb = it / nblk, nb = it % nblk, k0 = 64 * kb, n0 = 32 * nb;
        const int sc0 = blk > 0 ? (n0 / blk) * sblk + soff + (n0 % blk)
                                : (((nb >> 3) * 4 + (nb & 3)) * 128 + 32 * ((nb >> 2) & 1));
        float wv[32];
#pragma unroll
        for (int i = 0; i < 32; ++i) wv[i] = W[(size_t)(k0 + 2 * i + (lane >> 5)) * Nsrc + sc0 + (lane & 31)];
        if (gain) {
#pragma unroll
            for (int i = 0; i < 32; ++i) wv[i] *= gain[k0 + 2 * i + (lane >> 5)];
        }
#pragma unroll
        for (int i = 0; i < 32; ++i) scr[(2 * i + (lane >> 5)) * 33 + (lane & 31)] = wv[i];
        asm volatile("s_waitcnt lgkmcnt(0)" ::: "memory");
        const int c = lane & 7;
#pragma unroll
        for (int j = 0; j < 4; ++j) { const int n = (lane >> 3) + 8 * j; const LAS float* s = scr + (8 * c) * 33 + n;
            u32x4 o; o.x = pk2(s[0 * 33], s[1 * 33]); o.y = pk2(s[2 * 33], s[3 * 33]); o.z = pk2(s[4 * 33], s[5 * 33]); o.w = pk2(s[6 * 33], s[7 * 33]);
            *(u32x4*)(dst + (size_t)(n0 + n) * K + k0 + 8 * c) = o; }
        asm volatile("s_waitcnt lgkmcnt(0)" ::: "memory");
    }
}
__device__ __forceinline__ float row_to_bf16(const float* xr, bf16* orow, int lane) {
    f32x4 v[4]; float s = 0.f;
#pragma unroll
    for (int j = 0; j < 4; ++j) { v[j] = ((const f32x4*)xr)[lane + 64 * j]; s += (v[j][0] * v[j][0] + v[j][1] * v[j][1]) + (v[j][2] * v[j][2] + v[j][3] * v[j][3]); }
#pragma unroll
    for (int j = 0; j < 4; ++j) { u32x2 w; w.x = pk2(v[j][0], v[j][1]); w.y = pk2(v[j][2], v[j][3]); ((u32x2*)orow)[lane + 64 * j] = w; }
    return wave_sum(s);
}

#define RLX_AGENT __ATOMIC_RELAXED, __HIP_MEMORY_SCOPE_AGENT
#define XB_TMO      128
#define XB_XCNT(j)  (256  + 64 * (j))
#define XB_XSUB(j)  (1280 + 64 * (j))
#define XB_XGEN(j)  (2304 + 64 * (j))
#define XB_TOP      3328
#define XB_TOPGEN   3392
#define XCD_BAR_WORDS 3456
#define XB_SPIN_CAP (1u << 18)

__device__ __forceinline__ unsigned xb_ld(unsigned* p)              { return __hip_atomic_load(p, __ATOMIC_RELAXED, __HIP_MEMORY_SCOPE_AGENT); }
__device__ __forceinline__ unsigned xb_add(unsigned* p, unsigned v) { return __hip_atomic_fetch_add(p, v, __ATOMIC_RELAXED, __HIP_MEMORY_SCOPE_AGENT); }
__device__ __forceinline__ unsigned xb_xcc_id() { return (unsigned)__builtin_amdgcn_s_getreg((3 << 11) | 20) & 0xFu; }
#define XB_SPIN(cond, bar) do { unsigned _sp = 0; while (cond) { __builtin_amdgcn_s_sleep(1); \
    if ((++_sp & 255u) == 0u) { if (xb_ld(&(bar)[XB_TMO])) break; if (_sp > XB_SPIN_CAP) { atomicAdd(&(bar)[XB_TMO], 1u); break; } } } } while (0)

struct XcdBarrier {
    unsigned* bar; unsigned x;
    volatile LAS unsigned* st;
};

__device__ __forceinline__ XcdBarrier xcd_barrier_post(unsigned* bar, volatile LAS unsigned* st) {
    XcdBarrier b; b.bar = bar; b.x = xb_xcc_id(); b.st = st;
    if (threadIdx.x == 0) (void)xb_add(&bar[XB_XCNT(b.x)], 1u);
    return b;
}
__device__ __forceinline__ void xcd_barrier_complete(unsigned* bar, unsigned x, unsigned& nloc, unsigned& nx) {
    const unsigned G = gridDim.x * gridDim.y * gridDim.z;
    unsigned sum, cnt, mine, sp = 0u;
    for (;;) {
        sum = 0u; cnt = 0u; mine = 0u;
#pragma unroll
        for (unsigned j = 0; j < 16; ++j) { const unsigned c = xb_ld(&bar[XB_XCNT(j)]); sum += c; cnt += (c > 0u) ? 1u : 0u; mine = (j == x) ? c : mine; }
        if (sum == G) break;
        __builtin_amdgcn_s_sleep(1);
        if ((++sp & 255u) == 0u) { if (xb_ld(&bar[XB_TMO])) break; if (sp > XB_SPIN_CAP) { atomicAdd(&bar[XB_TMO], 1u); break; } }
    }
    nloc = mine > 0u ? mine : 1u; nx = cnt > 0u ? cnt : 1u;
}

__device__ __forceinline__ void xcd_barrier(const XcdBarrier& b) {
    asm volatile("s_waitcnt vmcnt(0)" ::: "memory");
    __syncthreads();
    if (threadIdx.x == 0) {
        unsigned* bar = b.bar;
        __builtin_amdgcn_s_waitcnt(0);
        unsigned nloc = b.st[0], nx = b.st[1];
        if (nloc == 0u) { xcd_barrier_complete(bar, b.x, nloc, nx); b.st[0] = nloc; b.st[1] = nx; }
        const unsigned old = xb_add(&bar[XB_XSUB(b.x)], 1u);
        const unsigned gen = old / nloc;
        if (old + 1u == (gen + 1u) * nloc) {
            __builtin_amdgcn_fence(__ATOMIC_RELEASE, "agent");
            asm volatile("s_waitcnt vmcnt(0)" ::: "memory");
            const unsigned og = xb_add(&bar[XB_TOP], 1u);
            const unsigned tg = og / nx;
            if (og + 1u == (tg + 1u) * nx) xb_add(&bar[XB_TOPGEN], 1u);
            else XB_SPIN(xb_ld(&bar[XB_TOPGEN]) == tg, bar);
            __builtin_amdgcn_fence(__ATOMIC_ACQUIRE, "agent");
            xb_add(&bar[XB_XGEN(b.x)], 1u);
            asm volatile("s_waitcnt vmcnt(0)" ::: "memory");
        } else {
            XB_SPIN(xb_ld(&bar[XB_XGEN(b.x)]) == gen, bar);
            __builtin_amdgcn_fence(__ATOMIC_ACQUIRE, "agent");
            asm volatile("s_waitcnt vmcnt(0)" ::: "memory");
        }
    }
    __syncthreads();
}


#define SS ((float*)(ws + OFF_SS))
#define MSS ((float*)(ws + OFF_MSS))
#define ROPE ((float*)(ws + OFF_ROPE))
#define WMKV ((bf16*)(ws + OFF_WMKV))
#define MEMB ((bf16*)(ws + OFF_MEMB))
#define MKVRAW ((float*)(ws + OFF_MKVRAW))
#define MK ((bf16*)(ws + OFF_MK))
#define MVT ((bf16*)(ws + OFF_MVT))
#define XB ((bf16*)(ws + OFF_XB))
#define LATC ((bf16*)(ws + OFF_LATC))
#define KR ((bf16*)(ws + OFF_KR))
#define UG ((bf16*)(ws + OFF_UG))
#define VG ((bf16*)(ws + OFF_VG))
#define Zb ((bf16*)(ws + OFF_Z))
#define CQ ((bf16*)(ws + OFF_CQ))
#define Hb ((bf16*)(ws + OFF_H))
#define QRAW ((bf16*)(ws + OFF_QRAW))
#define KRAW ((bf16*)(ws + OFF_KRAW))
#define QMRAW ((bf16*)(ws + OFF_QMRAW))
#define OM ((bf16*)(ws + OFF_OM))
#define VT ((bf16*)(ws + OFF_VT))
#define KH ((bf16*)(ws + OFF_KH))
#define KHS ((bf16*)(ws + OFF_KHS))
#define MIX ((bf16*)(ws + OFF_MIX))
#define HID ((bf16*)(ws + OFF_HID))
#ifndef EN_PRO
#define EN_PRO 1
#endif
#ifndef EN_GEMM
#define EN_GEMM 1
#endif
#ifndef EN_E1
#define EN_E1 1
#endif
#ifndef EN_E2
#define EN_E2 1
#endif
#ifndef EN_KB
#define EN_KB 1
#endif
#ifndef EN_ATT
#define EN_ATT 1
#endif
#ifndef EN_MATT
#define EN_MATT 1
#endif
__global__ void __launch_bounds__(512, 2) fwd_kernel(Params P) {
    extern __shared__ __attribute__((aligned(16))) unsigned char lds_raw[];
    LAS unsigned char* lds = (LAS unsigned char*)lds_raw;
    LAS char* ldc_ = (LAS char*)lds_raw;
    const int G = gridDim.x;
    float* dout = P.out;
    cg::grid_group grid = cg::this_grid();
    volatile LAS unsigned* MISC = (volatile LAS unsigned*)(lds + 131072 + 320);
    if (threadIdx.x < 32) MISC[threadIdx.x] = 0u;
    __syncthreads();
    XcdBarrier bar; bar.bar = (unsigned*)(P.ws + OFF_CTL); bar.x = 0; bar.st = MISC + 8;
    if (P.ph_hi - P.ph_lo > 1) bar = xcd_barrier_post((unsigned*)(P.ws + OFF_CTL), MISC + 8);

#ifndef REPEAT_SP
#define REPEAT_SP 0
#endif
#ifndef DOUBLE_SYNC
#define DOUBLE_SYNC 0
#endif
    int redone = 0; (void)redone;
#pragma unroll 1
    for (int ph = P.ph_lo; ph < P.ph_hi; ++ph) {
        int bid = blockIdx.x; asm volatile("" : "+s"(bid));
        unsigned char* ws = P.ws; asm volatile("" : "+s"(ws));
        const int NGW = G * 8, GT = G * 512;
#define PHASE_IDS int tid = threadIdx.x; asm volatile("" : "+v"(tid)); const int lane = tid & 63, wid = __builtin_amdgcn_readfirstlane(tid >> 6); const int gw = bid * 8 + wid, gtid = bid * 512 + tid; (void)gw; (void)gtid; (void)lane;
        const int l = (ph - 1) / 11, sp = (ph == 0) ? 0 : ((ph - 1) % 11) + 1;
        if (sp == 4 && !(REPEAT_SP == 4)) continue;
        unsigned char* wl = ws + OFF_W + (size_t)l * W_LAYER;
#define WIN ((bf16*)(wl + W_WIN))
#define WUQ ((bf16*)(wl + W_WUQ))
#define WK ((bf16*)(wl + W_WK))
#define WVT ((bf16*)(wl + W_WVT))
#define WOUT ((bf16*)(wl + W_WOUT))
#define WMQ ((bf16*)(wl + W_WMQ))
#define WMO ((bf16*)(wl + W_WMO))
#define WFF1 ((bf16*)(wl + W_FF1))
#define WFF2 ((bf16*)(wl + W_FF2))
#define SS1 (SS + (size_t)(3 * l) * TT)
#define SS2 (SS + (size_t)(3 * l + 1) * TT)
#define SS3 (SS + (size_t)(3 * l + 2) * TT)
#define SS1n (SS + (size_t)(3 * ((l + 1) & 1)) * TT)

        if (sp == 0 && EN_PRO) {
            PHASE_IDS
            LAS float* scr = (LAS float*)(lds + wid * 16384);
            int rot = 0;
#define CONVW(src, Nsrc, K, ndst, blk, sblk, soff, gain, dst) do { int gwr = gw - rot % NGW; if (gwr < 0) gwr += NGW; conv_w(src, Nsrc, K, ndst, blk, sblk, soff, gain, dst, scr, gwr, NGW, lane); rot += ((K) / 64) * ((ndst) / 32); } while (0)
#pragma unroll 1
            for (int ll = 0; ll < 2; ++ll) {
                unsigned char* w2 = ws + OFF_W + (size_t)ll * W_LAYER;
                CONVW(P.in[35] + (size_t)ll * 1024 * 4096, 4096, 1024, 4096, 4096, 4096, 0, P.in[34] + ll * 1024, (bf16*)(w2 + W_FF1));
                CONVW(P.in[36] + (size_t)ll * 4096 * 1024, 1024, 4096, 1024, 1024, 1024, 0, nullptr, (bf16*)(w2 + W_FF2));
                CONVW(P.in[9] + (size_t)ll * 1024 * 1440, 1440, 1024, 1440, 1440, 1440, 0, P.in[8] + ll * 1024, (bf16*)(w2 + W_WIN));
                CONVW(P.in[18] + (size_t)ll * 256 * 768, 768, 256, 768, 768, 768, 0, P.in[17] + ll * 256, (bf16*)(w2 + W_WUQ));
                CONVW(P.in[20] + (size_t)ll * 128 * 1024, 1024, 128, 512, -1, 128, 0, nullptr, (bf16*)(w2 + W_WK));
                CONVW(P.in[20] + (size_t)ll * 128 * 1024, 1024, 128, 512, 64, 128, 64, nullptr, (bf16*)(w2 + W_WVT));
                CONVW(P.in[25] + (size_t)ll * 1024 * 1024, 1024, 1024, 1024, 1024, 1024, 0, nullptr, (bf16*)(w2 + W_WOUT));
                CONVW(P.in[28] + (size_t)ll * 1024 * 512, 512, 1024, 512, 512, 512, 0, P.in[26] + ll * 1024, (bf16*)(w2 + W_WMQ));
                CONVW(P.in[29] + (size_t)ll * 1024 * 512, 512, 1024, 512, 512, 512, 0, P.in[27] + ll * 1024, WMKV + (size_t)(ll * 1024) * 1024);
                CONVW(P.in[30] + (size_t)ll * 1024 * 512, 512, 1024, 512, 512, 512, 0, P.in[27] + ll * 1024, WMKV + (size_t)(ll * 1024 + 512) * 1024);
                CONVW(P.in[31] + (size_t)ll * 512 * 1024, 1024, 512, 1024, 1024, 1024, 0, nullptr, (bf16*)(w2 + W_WMO));
#pragma unroll 1
                for (int i = gtid; i < 96 * 1024 / 8; i += GT) ((u32x4*)((bf16*)(w2 + W_WIN) + (size_t)1440 * 1024))[i] = (u32x4){0u, 0u, 0u, 0u};
            }
#pragma unroll 1
            for (int lb = 0; lb < 16; ++lb) { const int ll = lb >> 3, b2 = lb & 7;
                CONVW(P.in[7] + (size_t)(ll * 8 + b2) * 256 * 512, 512, 256, 512, 512, 512, 0, nullptr, MVT + (size_t)((ll * 12 + 4 + b2) * 4) * 128 * 256); }
#undef CONVW
#pragma unroll 1
            for (int row = gw; row < TV; row += 2 * NGW) {
                const int row2 = row + NGW; const bool has2 = row2 < TV;
                const float* xr = row < TP ? P.in[0] + (size_t)row * 1024 : P.in[1] + (size_t)(row - TP) * 1024;
                const float* xr2 = !has2 ? xr : row2 < TP ? P.in[0] + (size_t)row2 * 1024 : P.in[1] + (size_t)(row2 - TP) * 1024;
                f32x4 va[4], vb[4];
#pragma unroll
                for (int j = 0; j < 4; ++j) { va[j] = ((const f32x4*)xr)[lane + 64 * j]; vb[j] = ((const f32x4*)xr2)[lane + 64 * j]; }
                float sa = 0.f, sb = 0.f;
#pragma unroll
                for (int j = 0; j < 4; ++j) { sa += (va[j][0] * va[j][0] + va[j][1] * va[j][1]) + (va[j][2] * va[j][2] + va[j][3] * va[j][3]);
                    sb += (vb[j][0] * vb[j][0] + vb[j][1] * vb[j][1]) + (vb[j][2] * vb[j][2] + vb[j][3] * vb[j][3]);
                    u32x2 w; w.x = pk2(va[j][0], va[j][1]); w.y = pk2(va[j][2], va[j][3]); ((u32x2*)(XB + (size_t)row * 1024))[lane + 64 * j] = w;
                    if (has2) { w.x = pk2(vb[j][0], vb[j][1]); w.y = pk2(vb[j][2], vb[j][3]); ((u32x2*)(XB + (size_t)row2 * 1024))[lane + 64 * j] = w; } }
                sa = wave_sum(sa); sb = wave_sum(sb);
                if (lane == 0) { SS[row] = sa; if (has2) SS[row2] = sb; }
            }
            { int i = TV + gtid; while (i < 6 * TT) { SS[i] = 0.f; i += GT; asm volatile("" : "+v"(i)); } }
#pragma unroll 1
            for (int row = gw; row < 1024; row += NGW) { const float s = row_to_bf16(P.in[2] + (size_t)row * 1024, MEMB + (size_t)row * 1024, lane); if (lane == 0) MSS[row] = s; }
#pragma unroll 1
            for (int it = gw; it < 16 * 128; it += NGW) {
                const int k = it & 15, pos = (it >> 4) * 64 + lane, k3 = k & 3, k2 = k >> 2;
                const double b0 = k3 == 0 ? 1.0 : k3 == 1 ? 0.5623413251903491 : k3 == 2 ? 0.31622776601683794 : 0.1778279410038923;
                const double d0 = k2 == 0 ? 1.0 : k2 == 1 ? 0.1 : k2 == 2 ? 0.01 : 0.001;
                const double ang = (double)pos * (b0 * d0);
                const double kk = __builtin_rint(ang * 0.15915494309189535);
                const float r = (float)(ang - kk * 6.283185307179586);
                ROPE[2 * (pos * 16 + k)] = cosf(r); ROPE[2 * (pos * 16 + k) + 1] = sinf(r);
            }
#pragma unroll 1
            for (int row = gw; row < 2 * 8 * 256; row += NGW) {
                const int ll = row >> 11, b = (row >> 8) & 7, mm = row & 255, h = lane >> 4, d0 = 8 * (lane & 15);
                const float* ks = P.in[6] + (size_t)row * 512 + 8 * lane;
                const f32x4 k0 = *(const f32x4*)ks, k1 = *(const f32x4*)(ks + 4);
                u32x4 w; w.x = pk2(k0[0], k0[1]); w.y = pk2(k0[2], k0[3]); w.z = pk2(k1[0], k1[1]); w.w = pk2(k1[2], k1[3]);
                *(u32x4*)(MK + ((size_t)((ll * 12 + 4 + b) * 4 + h) * 256 + mm) * 128 + d0) = w;
            }
            __syncthreads();
        }

        {
            const int ng = !EN_GEMM ? 0 : (sp == 1) ? (l == 0 ? 2 : 1) : (sp == 3) ? 3 : (sp == 6 || sp == 7 || sp == 9 || sp == 10 || sp == 11) ? 1 : 0;
#pragma unroll 1
            for (int gi = 0; gi < ng; ++gi) {
                pg8::Gemm g; bool sk = true; EpiU E; E.mode = 0; E.relu2 = 0; E.out = nullptr; E.ldc = 0; E.ss = nullptr; E.ssdiv = 1.0f / 1024.0f; E.ssout = nullptr; E.base_p = nullptr; E.base_s = nullptr; E.xb = nullptr; E.gkn = nullptr; E.kr = nullptr; E.kh = nullptr; E.khs = nullptr;
                if (sp == 1 && gi == 0) { g = pg8::Gemm{XB, WIN, TP, 1536, 1024}; E.out = Hb; E.ldc = 1536; E.ss = SS1; }
                else if (sp == 1) { g = pg8::Gemm{MEMB, WMKV, 1024, 2048, 1024}; sk = false; E.mode = 2; E.out = MKVRAW; E.ldc = 2048; E.ss = MSS; }
                else if (sp == 3 && gi == 0) { g = pg8::Gemm{CQ, WUQ, TP, 768, 256}; E.out = QRAW; E.ldc = 768; }
                else if (sp == 3 && gi == 1) { g = pg8::Gemm{LATC, WK, LR, 512, 128}; sk = false; E.mode = 3; E.gkn = P.in[23] + l * 64; E.kr = KR; E.kh = KH; E.khs = KHS; }
                else if (sp == 3) { g = pg8::Gemm{WVT, LATC, 512, LR, 128}; sk = false; E.out = VT; E.ldc = LR; }
                else if (sp == 6) { g = pg8::Gemm{MIX, WOUT, TP, 1024, 1024}; E.mode = 1; E.out = nullptr; E.ldc = 1024; E.ssout = SS2; E.xb = XB; }
                else if (sp == 7) { g = pg8::Gemm{XB, WMQ, TP, 512, 1024}; E.out = QMRAW; E.ldc = 512; E.ss = SS2; }
                else if (sp == 9) { g = pg8::Gemm{OM, WMO, TP, 1024, 512}; E.mode = 1; E.out = nullptr; E.ldc = 1024; E.ssout = SS3; E.xb = XB; }
                else if (sp == 10) { g = pg8::Gemm{XB, WFF1, TP, 4096, 1024}; E.out = HID; E.ldc = 4096; E.ss = SS3; E.relu2 = 1; }
                else { g = pg8::Gemm{HID, WFF2, TP, 1024, 4096}; E.mode = 1; E.out = l == 1 ? dout : nullptr; E.ldc = 1024; E.ssout = SS1n; E.xb = XB; }
                const int rotc = (sp == 3 && (G & 7) == 0) ? (bid + G - (gi == 1 ? G / 2 : gi == 2 ? (3 * G) / 4 : 0)) % G : bid;
                pg8::StaticOrder S; S.init(g.M, g.N, G, rotc);
                if (E.mode != 2) { EpiP Ep; Ep.mode = E.mode; Ep.relu2 = E.relu2; Ep.out = E.out; Ep.ldc = E.ldc; Ep.ss = E.ss; Ep.ssdiv = E.ssdiv; Ep.ssout = E.ssout; Ep.xb = E.xb;
                    Ep.gkn = E.gkn; Ep.kr = E.kr; Ep.kh = E.kh; Ep.khs = E.khs;
                    pg8::gemm_phase<EpiP, pg8::StaticOrder, true, true>(lds, g, S, Ep); }
                else pg8::gemm_phase<EpiU, pg8::StaticOrder, true, true>(lds, g, S, E);
                __syncthreads();
                if (sk) { PHASE_IDS skinny_gemm(g.A + (size_t)TP * g.K, g.Bt, g.N, g.K, E, gw, NGW, lane); }
            }
        }

        if (sp == 2 && EN_E1) {
            PHASE_IDS
            const float* g_a = P.in[10] + l * 256; const float* g_kva = P.in[19] + l * 128; const float* g_kr = P.in[24] + l * 32;
            const f32x4 gA = *(const f32x4*)(g_a + 4 * lane), gKVA = *(const f32x4*)(g_kva + 4 * (lane & 31)), gKR = *(const f32x4*)(g_kr + 4 * (lane & 7));
            u32x2 cu = {0u, 0u}, cv = {0u, 0u}, ca = {0u, 0u}, cg_ = {0u, 0u}, cq = {0u, 0u}, cl = {0u, 0u}, ck = {0u, 0u};
            u32x2 nu = {0u, 0u}, nv = {0u, 0u}, na = {0u, 0u}, ng_ = {0u, 0u}, nq = {0u, 0u}, nl = {0u, 0u}, nk = {0u, 0u};
            if (gw < TV) { const bf16* h_ = Hb + (size_t)gw * 1536 + 4 * lane; cu = *(const u32x2*)(h_); cv = *(const u32x2*)(h_ + 256); ca = *(const u32x2*)(h_ + 512);
                cg_ = *(const u32x2*)(h_ + 768); cq = *(const u32x2*)(h_ + 1024); if (lane < 32) cl = *(const u32x2*)(h_ + 1280); if (lane < 8) ck = *(const u32x2*)(h_ + 1408); }
#pragma unroll 1
            for (int row = gw; row < TV; row += NGW) {
                if (row + NGW < TV) { const bf16* h_ = Hb + (size_t)(row + NGW) * 1536 + 4 * lane; nu = *(const u32x2*)(h_); nv = *(const u32x2*)(h_ + 256); na = *(const u32x2*)(h_ + 512);
                    ng_ = *(const u32x2*)(h_ + 768); nq = *(const u32x2*)(h_ + 1024); if (lane < 32) nl = *(const u32x2*)(h_ + 1280); if (lane < 8) nk = *(const u32x2*)(h_ + 1408); }
                const bool samp = row >= TP;
                int b, t; if (!samp) { b = row >> 13; t = row & 8191; } else { b = (row - TP) >> 4; t = (row - TP) & 15; }
                const int pos = samp ? 1024 + t : t; const int c4 = 4 * lane;
                const float* rp = ROPE + (size_t)pos * 32 + 8 * (lane & 3); const f32x4 cs0 = *(const f32x4*)rp, cs1 = *(const f32x4*)(rp + 4);
                {
                    const u32x2 r = cu; u32x2 w; w.x = pk2(gelu_f(bflo(r.x)), gelu_f(bfhi(r.x))); w.y = pk2(gelu_f(bflo(r.y)), gelu_f(bfhi(r.y)));
                    *(u32x2*)(UG + (size_t)row * 256 + c4) = w; }
                {
                    const u32x2 r = cv; float v0 = gelu_f(bflo(r.x)), v1 = gelu_f(bfhi(r.x)), v2 = gelu_f(bflo(r.y)), v3 = gelu_f(bfhi(r.y));
                    const float rs = rsqrtf(wave_sum((v0 * v0 + v1 * v1) + (v2 * v2 + v3 * v3)) * (1.0f / 256.0f) + EPS); const f32x4 g = gA;
                    v0 *= rs * g[0]; v1 *= rs * g[1]; v2 *= rs * g[2]; v3 *= rs * g[3];
                    u32x2 w; w.x = pk2(v0, v1); w.y = pk2(v2, v3); *(u32x2*)(VG + (size_t)row * 256 + c4) = w;
                    if (samp) *(f32x4*)(dout + O_GVS + ((size_t)(l * 8 + b) * 16 + t) * 256 + c4) = (f32x4){v0, v1, v2, v3}; }
                {
                    const u32x2 a = ca, gt = cg_;
                    const float z0 = bflo(a.x) * sigm_f(bflo(gt.x)), z1 = bfhi(a.x) * sigm_f(bfhi(gt.x)), z2 = bflo(a.y) * sigm_f(bflo(gt.y)), z3 = bfhi(a.y) * sigm_f(bfhi(gt.y));
                    u32x2 w; w.x = pk2(z0, z1); w.y = pk2(z2, z3); *(u32x2*)(Zb + (size_t)row * 256 + c4) = w;
                    if (!samp) { if (t >= 8162) *(f32x4*)(dout + O_CONVP + ((size_t)(l * 4 + b) * 30 + (t - 8162)) * 256 + c4) = (f32x4){z0, z1, z2, z3}; }
                    else { *(f32x4*)(dout + O_CONVS + ((size_t)(l * 8 + b) * 30 + 14 + t) * 256 + c4) = (f32x4){z0, z1, z2, z3};
                           if (t < 14) *(f32x4*)(dout + O_CONVS + ((size_t)(l * 8 + b) * 30 + t) * 256 + c4) = *(const f32x4*)(P.in[5] + ((size_t)(l * 8 + b) * 30 + 16 + t) * 256 + c4); } }
                {
                    const u32x2 r = cq; float v0 = bflo(r.x), v1 = bfhi(r.x), v2 = bflo(r.y), v3 = bfhi(r.y);
                    const float rs = rsqrtf(wave_sum((v0 * v0 + v1 * v1) + (v2 * v2 + v3 * v3)) * (1.0f / 256.0f) + EPS);
                    u32x2 w; w.x = pk2(v0 * rs, v1 * rs); w.y = pk2(v2 * rs, v3 * rs); *(u32x2*)(CQ + (size_t)row * 256 + c4) = w; }
                const size_t lrow = samp ? (size_t)TP + b * SKV + 1024 + t : (size_t)row;
                {
                    float v0 = 0.f, v1 = 0.f, v2 = 0.f, v3 = 0.f;
                    if (lane < 32) { const u32x2 r = cl; v0 = bflo(r.x); v1 = bfhi(r.x); v2 = bflo(r.y); v3 = bfhi(r.y); }
                    const float rs = rsqrtf(wave_sum((v0 * v0 + v1 * v1) + (v2 * v2 + v3 * v3)) * (1.0f / 128.0f) + EPS);
                    if (lane < 32) { const f32x4 g = gKVA; v0 *= rs * g[0]; v1 *= rs * g[1]; v2 *= rs * g[2]; v3 *= rs * g[3];
                        float* op = samp ? dout + O_LATS + ((size_t)(l * 8 + b) * 16 + t) * 128 : dout + O_LATP + ((size_t)(l * 4 + b) * 8192 + t) * 128;
                        *(f32x4*)(op + c4) = (f32x4){v0, v1, v2, v3}; u32x2 w; w.x = pk2(v0, v1); w.y = pk2(v2, v3); *(u32x2*)(LATC + lrow * 128 + c4) = w; } }
                {
                    float v0 = 0.f, v1 = 0.f, v2 = 0.f, v3 = 0.f;
                    if (lane < 8) { const u32x2 r = ck; v0 = bflo(r.x); v1 = bfhi(r.x); v2 = bflo(r.y); v3 = bfhi(r.y); }
                    const float rs = rsqrtf(wave_sum((v0 * v0 + v1 * v1) + (v2 * v2 + v3 * v3)) * (1.0f / 32.0f) + EPS);
                    if (lane < 8) { const f32x4 g = gKR; v0 *= rs * g[0]; v1 *= rs * g[1]; v2 *= rs * g[2]; v3 *= rs * g[3]; }
#define XOR4(v) __builtin_bit_cast(float, __builtin_amdgcn_ds_bpermute((lane ^ 4) << 2, __builtin_bit_cast(int, (v))))
                    const float o0 = XOR4(v0), o1 = XOR4(v1), o2 = XOR4(v2), o3 = XOR4(v3);
#undef XOR4
                    if (lane < 8) {
                        float r0, r1, r2, r3;
                        if (lane < 4) { r0 = v0 * cs0[0] - o0 * cs0[1]; r1 = v1 * cs0[2] - o1 * cs0[3]; r2 = v2 * cs1[0] - o2 * cs1[1]; r3 = v3 * cs1[2] - o3 * cs1[3]; }
                        else          { r0 = o0 * cs0[1] + v0 * cs0[0]; r1 = o1 * cs0[3] + v1 * cs0[2]; r2 = o2 * cs1[1] + v2 * cs1[0]; r3 = o3 * cs1[3] + v3 * cs1[2]; }
                        float* op = samp ? dout + O_KRS + ((size_t)(l * 8 + b) * 16 + t) * 32 : dout + O_KRP + ((size_t)(l * 4 + b) * 8192 + t) * 32;
                        *(f32x4*)(op + c4) = (f32x4){r0, r1, r2, r3}; u32x2 w; w.x = pk2(r0, r1); w.y = pk2(r2, r3); *(u32x2*)(KR + lrow * 32 + c4) = w; } }
                cu = nu; cv = nv; ca = na; cg_ = ng_; cq = nq; cl = nl; ck = nk;
            }
#pragma unroll 1
            for (int i = gtid; i < 8 * 1024 * 16; i += GT) { const int b = i >> 14, t = (i >> 4) & 1023, c = i & 15;
                const float* s = P.in[3] + ((size_t)(l * 8 + b) * 1024 + t) * 128 + 8 * c; const f32x4 a = *(const f32x4*)s, bb = *(const f32x4*)(s + 4);
                u32x4 w; w.x = pk2(a[0], a[1]); w.y = pk2(a[2], a[3]); w.z = pk2(bb[0], bb[1]); w.w = pk2(bb[2], bb[3]);
                *(u32x4*)(LATC + ((size_t)TP + b * SKV + t) * 128 + 8 * c) = w; }
#pragma unroll 1
            for (int i = gtid; i < 8 * 1024 * 4; i += GT) { const int b = i >> 12, t = (i >> 2) & 1023, c = i & 3;
                const float* s = P.in[4] + ((size_t)(l * 8 + b) * 1024 + t) * 32 + 8 * c; const f32x4 a = *(const f32x4*)s, bb = *(const f32x4*)(s + 4);
                u32x4 w; w.x = pk2(a[0], a[1]); w.y = pk2(a[2], a[3]); w.z = pk2(bb[0], bb[1]); w.w = pk2(bb[2], bb[3]);
                *(u32x4*)(KR + ((size_t)TP + b * SKV + t) * 32 + 8 * c) = w; }
            if (l == 0) {
#pragma unroll 1
                for (int it = gw; it < 2048; it += NGW) { const int ll = it >> 10, row = it & 1023, b = row >> 8, mm = row & 255, h = lane >> 4, d0 = 8 * (lane & 15);
                    const float* kp = MKVRAW + (size_t)row * 2048 + ll * 1024 + 8 * lane; const float* vp = kp + 512;
                    f32x4 k0 = *(const f32x4*)kp, k1 = *(const f32x4*)(kp + 4); const f32x4 v0 = *(const f32x4*)vp, v1 = *(const f32x4*)(vp + 4);
                    float s = (k0[0] * k0[0] + k0[1] * k0[1]) + (k0[2] * k0[2] + k0[3] * k0[3]) + (k1[0] * k1[0] + k1[1] * k1[1]) + (k1[2] * k1[2] + k1[3] * k1[3]);
                    s = sum16(s);
                    const float rs = rsqrtf(s * (1.0f / 128.0f) + EPS); const float* gk = P.in[33] + ll * 128 + d0;
                    const f32x4 g0 = *(const f32x4*)gk, g1 = *(const f32x4*)(gk + 4); k0 = k0 * rs * g0; k1 = k1 * rs * g1;
                    float* ok = dout + O_MKP + ((size_t)(ll * 4 + b) * 256 + mm) * 512 + 8 * lane; float* ov = dout + O_MVP + ((size_t)(ll * 4 + b) * 256 + mm) * 512 + 8 * lane;
                    *(f32x4*)ok = k0; *(f32x4*)(ok + 4) = k1; *(f32x4*)ov = v0; *(f32x4*)(ov + 4) = v1;
                    u32x4 w; w.x = pk2(k0[0], k0[1]); w.y = pk2(k0[2], k0[3]); w.z = pk2(k1[0], k1[1]); w.w = pk2(k1[2], k1[3]);
                    *(u32x4*)(MK + ((size_t)((ll * 12 + b) * 4 + h) * 256 + mm) * 128 + d0) = w;
                }
                LAS float* scr = (LAS float*)(lds + wid * 16384);
#pragma unroll 1
                for (int lb = 0; lb < 8; ++lb) { const int ll = lb >> 2, b2 = lb & 3; int gwr = gw - (lb * 64) % NGW; if (gwr < 0) gwr += NGW;
                    conv_w(MKVRAW + (size_t)(b2 * 256) * 2048 + ll * 1024 + 512, 2048, 256, 512, 512, 512, 0, nullptr, MVT + (size_t)((ll * 12 + b2) * 4) * 128 * 256, scr, gwr, NGW, lane); }
            }
        }

        if (sp == 3 && EN_E2) {
            PHASE_IDS
            constexpr int GV_OFF = 128 * 272;
#pragma unroll 1
            for (int g = 0; g < 4; ++g) {
                const float* wsg = P.in[11] + ((size_t)(l * 4 + g) * 128) * 128; const float* bsg = P.in[12] + (l * 4 + g) * 128;
#pragma unroll 1
                for (int c = tid; c < 128 * 16; c += 512) { const int i = c >> 4, j0 = (c & 15) * 8; const f32x4 a = *(const f32x4*)(wsg + i * 128 + j0), b2 = *(const f32x4*)(wsg + i * 128 + j0 + 4);
                    float e[8] = {a[0], a[1], a[2], a[3], b2[0], b2[1], b2[2], b2[3]};
#pragma unroll
                    for (int k = 0; k < 8; ++k) if (j0 + k > i) e[k] = 0.f;
                    u32x4 w; w.x = pk2(e[0], e[1]); w.y = pk2(e[2], e[3]); w.z = pk2(e[4], e[5]); w.w = pk2(e[6], e[7]);
                    *(LAS u32x4*)(lds + i * 272 + j0 * 2) = w; }
#pragma unroll 1
                for (int u = bid; u < 256 + 256; u += G) {
                    if (u >= 256 && !(G == 256 ? (u - 256 >= 224 && ((u - 256 - 224) >> 3) == g) : (u - 256 < 8))) continue;
                    const int row0 = u < 256 ? 128 * u : TP + 16 * ((u - 256) & 7), nrows = u < 256 ? 128 : 16;
#pragma unroll 1
                    for (int c = tid; c < 128 * 16; c += 512) { const int j = c >> 4, d0 = (c & 15) * 4; u32x2 v = {0u, 0u};
                        if (j < nrows) v = *(const u32x2*)(VG + (size_t)(row0 + j) * 256 + g * 64 + d0);
                        *(LAS bf16*)(lds + GV_OFF + (d0 + 0) * 272 + j * 2) = (bf16)(v.x & 0xffffu); *(LAS bf16*)(lds + GV_OFF + (d0 + 1) * 272 + j * 2) = (bf16)(v.x >> 16);
                        *(LAS bf16*)(lds + GV_OFF + (d0 + 2) * 272 + j * 2) = (bf16)(v.y & 0xffffu); *(LAS bf16*)(lds + GV_OFF + (d0 + 3) * 272 + j * 2) = (bf16)(v.y >> 16); }
                    __syncthreads();
                    if (wid * 16 < nrows) {
                        pg8::f32x4 acc[4];
#pragma unroll
                        for (int dt = 0; dt < 4; ++dt) acc[dt] = (pg8::f32x4){0.f, 0.f, 0.f, 0.f};
                        const int i = 16 * wid + (lane & 15), kb = lane >> 4, nks = (16 * wid + 15) / 32 + 1;
                        for (int ks = 0; ks < nks; ++ks) {
                            const bf16x8 a = *(const LAS bf16x8*)(lds + i * 272 + (32 * ks + 8 * kb) * 2);
#pragma unroll
                            for (int dt = 0; dt < 4; ++dt) { const bf16x8 bfr = *(const LAS bf16x8*)(lds + GV_OFF + (16 * dt + (lane & 15)) * 272 + (32 * ks + 8 * kb) * 2);
                                acc[dt] = __builtin_amdgcn_mfma_f32_16x16x32_bf16(bfr, a, acc[dt], 0, 0, 0); }
                        }
                        const int ii = 16 * wid + (lane & 15); const float bsi = bsg[ii];
#pragma unroll
                        for (int dt = 0; dt < 4; ++dt) { const int d = 16 * dt + 4 * (lane >> 4);
                            const u32x2 uu = *(const u32x2*)(UG + (size_t)(row0 + ii) * 256 + g * 64 + d);
                            u32x2 w; w.x = pk2((acc[dt][0] + bsi) * bflo(uu.x), (acc[dt][1] + bsi) * bfhi(uu.x)); w.y = pk2((acc[dt][2] + bsi) * bflo(uu.y), (acc[dt][3] + bsi) * bfhi(uu.y));
                            *(u32x2*)(MIX + (size_t)(row0 + ii) * 1024 + g * 64 + d) = w; }
                    }
                    __syncthreads();
                }
            }
            const float* dww = P.in[13] + (size_t)l * 31 * 256; const float* dwb = P.in[14] + l * 256; const float* lng = P.in[15] + l * 256; const float* lnb = P.in[16] + l * 256;
            const f32x4 bias = *(const f32x4*)(dwb + 4 * lane), gg = *(const f32x4*)(lng + 4 * lane), bb = *(const f32x4*)(lnb + 4 * lane);
#pragma unroll 1
            for (int u0 = bid; u0 < 1024 + 256; u0 += G) {
                int u = u0;
                if (u0 >= 1024) { const int j = u0 - 1024; if (G == 256 ? (j < 216 || j >= 224) : (j >= 8)) continue; u = 1024 + (j & 7); }
                const bool samp = u >= 1024; const int b = samp ? u - 1024 : u >> 8; const int zrow0 = samp ? TP + 16 * b : b * 8192 + 32 * (u & 255);
                const int ntok = samp ? 16 : 32; const bool zero_hist = !samp && (u & 255) == 0; const float* hist = samp ? P.in[5] + (size_t)(l * 8 + b) * 30 * 256 : nullptr;
                const int nrows = 30 + ntok;
#pragma unroll 1
                for (int c = tid; c < nrows * 32; c += 512) { const int rr = c >> 5, cc = (c & 31) * 8; u32x4 v = {0u, 0u, 0u, 0u};
                    if (rr < 30) { if (hist) { const f32x4 a = *(const f32x4*)(hist + rr * 256 + cc), b2 = *(const f32x4*)(hist + rr * 256 + cc + 4); v.x = pk2(a[0], a[1]); v.y = pk2(a[2], a[3]); v.z = pk2(b2[0], b2[1]); v.w = pk2(b2[2], b2[3]); }
                                   else if (!zero_hist) v = *(const u32x4*)(Zb + (size_t)(zrow0 - 30 + rr) * 256 + cc); }
                    else v = *(const u32x4*)(Zb + (size_t)(zrow0 + rr - 30) * 256 + cc);
                    *(LAS u32x4*)(lds + rr * 512 + cc * 2) = v; }
                __syncthreads();
                {
                    const int tpw = ntok >> 3;
                    const int c4 = 4 * lane; f32x4 acc[4];
#pragma unroll
                    for (int j = 0; j < 4; ++j) acc[j] = bias;
#pragma unroll 1
                    for (int k = 0; k < 31; ++k) { const f32x4 w = *(const f32x4*)(dww + k * 256 + c4);
#pragma unroll
                        for (int j = 0; j < 4; ++j) if (j < tpw) { const u32x2 z = *(const LAS u32x2*)(lds + (tpw * wid + j + k) * 512 + c4 * 2);
                            acc[j][0] += w[0] * bflo(z.x); acc[j][1] += w[1] * bfhi(z.x); acc[j][2] += w[2] * bflo(z.y); acc[j][3] += w[3] * bfhi(z.y); } }
#pragma unroll
                    for (int j = 0; j < 4; ++j) if (j < tpw) { const float mean = wave_sum((acc[j][0] + acc[j][1]) + (acc[j][2] + acc[j][3])) * (1.0f / 256.0f);
                        const f32x4 xc = acc[j] - mean; const float var = wave_sum((xc[0] * xc[0] + xc[1] * xc[1]) + (xc[2] * xc[2] + xc[3] * xc[3])) * (1.0f / 256.0f);
                        const float rs = rsqrtf(var + EPS); f32x4 y = xc * rs * gg + bb;
                        y[0] *= sigm_f(y[0]); y[1] *= sigm_f(y[1]); y[2] *= sigm_f(y[2]); y[3] *= sigm_f(y[3]);
                        u32x2 w2; w2.x = pk2(y[0], y[1]); w2.y = pk2(y[2], y[3]); *(u32x2*)(MIX + (size_t)(zrow0 + tpw * wid + j) * 1024 + 256 + c4) = w2; }
                }
                __syncthreads();
            }
        }

        if (false) {
            PHASE_IDS
            const float* gkn = P.in[23] + l * 64;
#pragma unroll 1
            for (int r = gw; r < LRV; r += NGW) {
                const u32x4 raw = *(const u32x4*)(KRAW + (size_t)r * 512 + 8 * lane);
                float x[8] = {bflo(raw.x), bfhi(raw.x), bflo(raw.y), bfhi(raw.y), bflo(raw.z), bfhi(raw.z), bflo(raw.w), bfhi(raw.w)};
                float s = 0.f;
#pragma unroll
                for (int j = 0; j < 8; ++j) s += x[j] * x[j];
                s = sum8(s);
                const float rs = rsqrtf(s * (1.0f / 64.0f) + EPS); const int hh = lane >> 3, d0 = 8 * (lane & 7);
                const f32x4 g0 = *(const f32x4*)(gkn + d0), g1 = *(const f32x4*)(gkn + d0 + 4);
                u32x4 w; w.x = pk2(x[0] * rs * g0[0], x[1] * rs * g0[1]); w.y = pk2(x[2] * rs * g0[2], x[3] * rs * g0[3]); w.z = pk2(x[4] * rs * g1[0], x[5] * rs * g1[1]); w.w = pk2(x[6] * rs * g1[2], x[7] * rs * g1[3]);
                bf16* dst;
                if (r < TP) { const int b = r >> 13, t = r & 8191; dst = KH + ((size_t)(b * 8 + hh) * 8192 + t) * 96; }
                else { const int rr = r - TP, b = rr / SKV, t = rr - b * SKV; dst = KHS + ((size_t)(b * 8 + hh) * KHS_T + t) * 96; }
                *(u32x4*)(dst + d0) = w;
                *(u32x2*)(dst + 64 + 4 * (lane & 7)) = *(const u32x2*)(KR + (size_t)r * 32 + 4 * (lane & 7));
            }
        }

        if (sp == 5 && EN_ATT) {
            PHASE_IDS
            const float* gqn = P.in[21] + l * 64; const float* gqr = P.in[22] + l * 32;
            const int r32 = lane & 31, hi = lane >> 5;
            const int vcu = (bid & 7) * 32 + (bid >> 3);
#pragma unroll 1
            for (int ui = 0;; ++ui) {
                int bh, qb;
                if (G == 256) { if (ui >= 4) break; const int xcd = bid & 7, v = bid >> 3, s = v & 15;
                    bh = 4 * xcd + 2 * (ui >> 1) + (v >> 4); qb = (ui & 1) ? 31 - s : s; }
                else { const int u = bid + ui * G; if (u >= 1024) break; bh = u >> 5; qb = u & 31; }
                const int b = bh >> 3, h = bh & 7; const int t = qb * 256 + wid * 32 + r32; const size_t row = (size_t)b * 8192 + t;
                bf16x8 q[6]; load_q_mla(q, QRAW + row * 768 + h * 96, hi, gqn, gqr, ROPE + (size_t)t * 32);
                f32x16 o[2]; float lsum;
                attn_block<96, 64>(ldc_, q, KH + (size_t)bh * 8192 * 96, VT + (size_t)(h * 64) * LR + (size_t)b * 8192, LR, 4 * qb + 4, 4 * qb + (wid >> 1) + 1, 1 << 30, o, lsum);
                attn_store<2>(o, lsum, MIX + row * 1024 + 512 + h * 64, hi, true);
            }
#pragma unroll 1
            for (int u = bid; u < 64; u += G) {
                const int b = u >> 3, h = u & 7, tq = min(r32, 15); const size_t row = (size_t)TP + b * 16 + tq;
                bf16x8 q[6]; load_q_mla(q, QRAW + row * 768 + h * 96, hi, gqn, gqr, ROPE + (size_t)(1024 + tq) * 32);
                f32x16 o[2]; float lsum;
                attn_block<96, 64>(ldc_, q, KHS + (size_t)(b * 8 + h) * KHS_T * 96, VT + (size_t)(h * 64) * LR + TP + b * SKV, LR, 17, wid == 0 ? 17 : 0, SKV, o, lsum);
                attn_store<2>(o, lsum, MIX + row * 1024 + 512 + h * 64, hi, wid == 0 && r32 < 16);
            }
        }

        if (sp == 8 && EN_MATT) {
            PHASE_IDS
            const float* gq = P.in[32] + l * 128; const int r32 = lane & 31, hi = lane >> 5;
#pragma unroll 1
            for (int u = bid; u < 512; u += G) {
                const int b = u >> 7, h = (u >> 5) & 3, qt = u & 31; const size_t row = (size_t)b * 8192 + qt * 256 + wid * 32 + r32;
                bf16x8 q[8]; load_q_mem(q, QMRAW + row * 512 + h * 128, hi, gq);
                f32x16 o[4]; float lsum;
                attn_block<128, 128>(ldc_, q, MK + (size_t)((l * 12 + b) * 4 + h) * 256 * 128, MVT + (size_t)((l * 12 + b) * 4 + h) * 128 * 256, 256, 4, 4, 1 << 30, o, lsum);
                attn_store<4>(o, lsum, OM + row * 512 + h * 128, hi, true);
            }
#pragma unroll 1
            for (int u = bid; u < 32; u += G) {
                const int b = u >> 2, h = u & 3, tq = min(r32, 15); const size_t row = (size_t)TP + b * 16 + tq;
                bf16x8 q[8]; load_q_mem(q, QMRAW + row * 512 + h * 128, hi, gq);
                f32x16 o[4]; float lsum;
                attn_block<128, 128>(ldc_, q, MK + (size_t)((l * 12 + 4 + b) * 4 + h) * 256 * 128, MVT + (size_t)((l * 12 + 4 + b) * 4 + h) * 128 * 256, 256, 4, wid == 0 ? 4 : 0, 256, o, lsum);
                attn_store<4>(o, lsum, OM + row * 512 + h * 128, hi, wid == 0 && r32 < 16);
            }
        }

        if (ph + 1 < P.ph_hi) { if (P.ph_hi > NPHASE) grid.sync(); else xcd_barrier(bar); }
#if REPEAT_SP
        if ((REPEAT_SP == 100 ? sp == 0 : sp == REPEAT_SP) && !redone) { redone = 1; --ph; } else redone = 0;
#endif
#if DOUBLE_SYNC
        if (ph + 1 < P.ph_hi) xcd_barrier(bar);
#endif
    }
}

#ifndef MULTI_LAUNCH
#define MULTI_LAUNCH 0
#endif
extern "C" void kernel_launch(void* const* d_in, const int* in_sizes, int n_in, void* d_out, int out_size, void* d_ws, size_t ws_size, hipStream_t stream) {
    static int grid = 0;
    if (grid == 0) {
        if (n_in != 37 || out_size != (int)O_END || ws_size < WS_END) { fprintf(stderr, "kernel_launch: unexpected shapes n_in %d out %d ws %zu (need %zu)\n", n_in, out_size, ws_size, (size_t)WS_END); grid = -1; return; }
        int dev = 0, cus = 0, per_cu = 0;
        hipGetDevice(&dev); hipDeviceGetAttribute(&cus, hipDeviceAttributeMultiprocessorCount, dev);
        hipFuncSetAttribute((const void*)fwd_kernel, hipFuncAttributeMaxDynamicSharedMemorySize, LDS_BYTES);
        hipOccupancyMaxActiveBlocksPerMultiprocessor(&per_cu, (const void*)fwd_kernel, 512, LDS_BYTES);
        if (per_cu < 1) per_cu = 1;
        (void)hipGetLastError();
        grid = cus * per_cu;
        if (grid > 256) grid = 256;
    }
    if (grid < 0) return;
    if (hipMemsetAsync((char*)d_ws + OFF_CTL, 0, CTL_BYTES, stream) != hipSuccess) { fprintf(stderr, "kernel_launch: memset failed\n"); return; }
    Params p{};
    for (int i = 0; i < 37; ++i) p.in[i] = (const float*)d_in[i];
    p.out = (float*)d_out; p.ws = (unsigned char*)d_ws;
#if MULTI_LAUNCH
    for (int ph = 0; ph < NPHASE; ++ph) { p.ph_lo = ph; p.ph_hi = ph + 1; hipLaunchKernelGGL(fwd_kernel, dim3(grid), dim3(512), LDS_BYTES, stream, p); }
#else
    p.ph_lo = 0; p.ph_hi = NPHASE;
    void* args[] = {&p};
    hipError_t e = hipLaunchCooperativeKernel((const void*)fwd_kernel, dim3(grid), dim3(512), args, LDS_BYTES, stream);
    if (e != hipSuccess) fprintf(stderr, "cooperative launch failed: %s (grid %d)\n", hipGetErrorString(e), grid);
#endif
}
```

```cpp
#include <hip/hip_runtime.h>
#include <hip/hip_cooperative_groups.h>
#include <cstdio>
#include <cstdint>
namespace cg = cooperative_groups;
namespace pg8 {
#define PG8_LAS __attribute__((address_space(3)))
typedef unsigned short bf16_t;
typedef short bf16x8 __attribute__((ext_vector_type(8)));
typedef float f32x4 __attribute__((ext_vector_type(4)));
typedef unsigned u32x4 __attribute__((ext_vector_type(4)));
constexpr int BM = 256, BK = 64, HALF = 128, HTB = HALF * BK * 2  , STAGE_BYTES = 8 * HTB, NXCD = 8, WGM = 8;

__host__ __device__ __forceinline__ int lds_byte(int r, int c) { const int st = (r >> 4) * 2 + (c >> 5), rr = r & 15, cc = c & 31, ob = rr * 64 + cc * 2; return st * 1024 + (ob ^ (((ob >> 9) & 1) << 5)); }
__host__ __device__ __forceinline__ void stage_rc(int b, int& R, int& C) { const int st = b / 1024, sb = b % 1024, swz = sb ^ (((sb >> 9) & 1) << 5); R = (st >> 1) * 16 + swz / 64; C = (st & 1) * 32 + (swz % 64) / 2; }
__host__ __device__ __forceinline__ int perm32(int rho) { const int n = rho >> 4, i = rho & 15; return 8 * (i >> 2) + 4 * n + (i & 3); }

struct Unit { int pm, pn; };
struct Gemm { const bf16_t* A; const bf16_t* Bt; int M, N, K; };

struct StaticOrder {
    int nM, nN, nwg, G, c;
    __host__ __device__ void init(int M, int N, int G_, int c_) { nM = M / BM; nN = N / BM; nwg = nM * nN; G = G_; c = c_; }
    __host__ __device__ bool next(int i, Unit& u) const {
        const long L = (long)i * G + c; if (L >= nwg) return false;
        int wgid = (int)L; { const int q = nwg / NXCD, r = nwg % NXCD, xcd = wgid % NXCD, off = wgid / NXCD; wgid = (xcd < r ? xcd * (q + 1) : r * (q + 1) + (xcd - r) * q) + off; }
        const int nig = WGM * nN, gid = wgid / nig, fm = gid * WGM, gsz = (nM - fm) < WGM ? (nM - fm) : WGM;
        u.pm = fm + ((wgid % nig) % gsz); u.pn = (wgid % nig) / gsz; return true;
    }
    __device__ __forceinline__ void a_ready(const Unit&) const {}
    __device__ __forceinline__ void done(const Unit&) const {}
};

__device__ __forceinline__ unsigned cvt_pk_bf16(float lo, float hi) { unsigned r; asm volatile("v_cvt_pk_bf16_f32 %0, %1, %2" : "=v"(r) : "v"(lo), "v"(hi)); return r; }
typedef float f32x2 __attribute__((ext_vector_type(2)));
__device__ __forceinline__ f32x2 gelu_pk(f32x2 v) {
    const f32x2 av = __builtin_elementwise_abs(v), d = av * 0.2316418882f + 1.0f;
    f32x2 t; t.x = __builtin_amdgcn_rcpf(d.x); t.y = __builtin_amdgcn_rcpf(d.y);
    f32x2 q = t * 0.5307027145f + (-0.7265760135f); q = q * t + 0.7107068705f; q = q * t + (-0.142248368f); q = q * t + 0.127414796f; q = q * t;
    const f32x2 s = (v * v) * (-0.72134752044f);
    f32x2 e; e.x = __builtin_amdgcn_exp2f(s.x); e.y = __builtin_amdgcn_exp2f(s.y);
    const f32x2 m = v * (q * e), r = v - m;
    f32x2 o; o.x = v.x < 0.f ? m.x : r.x; o.y = v.y < 0.f ? m.y : r.y; return o;
}

template <class Epi, class Sched, bool ALIGN_EPI = false, bool SP2 = false>
__device__ __forceinline__ void gemm_phase(PG8_LAS unsigned char* lds, const Gemm g, const Sched& S, const Epi& E) {
    int tid = threadIdx.x; asm volatile("" : "+v"(tid));
    const int wid = __builtin_amdgcn_readfirstlane(tid >> 6), lane = tid & 63, wr = wid >> 2, wc = wid & 3, fr = lane & 15, fq = lane >> 4;
    const int K = g.K, nt = K / BK;
    unsigned voffA[2], voffB[2];
#pragma unroll
    for (int i = 0; i < 2; ++i) { int R, C; stage_rc(tid * 16 + i * 8192, R, C); const int Rb = Epi::PERM ? ((R & ~31) + perm32(R & 31)) : R;
        voffA[i] = (unsigned)(R * K + C) * 2u; voffB[i] = (unsigned)(Rb * K + C) * 2u; }
    const size_t kstep = (size_t)(BK * 2);
    const size_t hstep = (size_t)HALF * K * 2;
    const size_t tstep = 2 * hstep;
    const unsigned ldsw = (unsigned)wid * 1024u;
    const int aoff = lds_byte(wr * 64 + fr, fq * 8), boff = lds_byte(wc * 32 + fr, fq * 8);
#define PG8_SA(b, h) (((b) * 2 + (h)) * HTB)
#define PG8_SB(b, h) ((4 + (b) * 2 + (h)) * HTB)
#define PG8_STAGE(bufoff, gbase, voff) do { _Pragma("unroll") for (int _i = 0; _i < 2; ++_i) \
        __builtin_amdgcn_global_load_lds((const unsigned*)((const char*)(gbase) + (voff)[_i]), (PG8_LAS unsigned*)(lds + (bufoff) + ldsw + _i * 8192), 16, 0, 0); } while (0)
#define PG8_LDA(dst, b, h) do { _Pragma("unroll") for (int m = 0; m < 4; ++m) _Pragma("unroll") for (int k = 0; k < 2; ++k) dst[m][k] = *(const PG8_LAS bf16x8*)(lds + PG8_SA(b, h) + aoff + m * 2048 + k * 1024); } while (0)
#define PG8_LDB(dst, b, h) do { _Pragma("unroll") for (int n = 0; n < 2; ++n) _Pragma("unroll") for (int k = 0; k < 2; ++k) dst[n][k] = *(const PG8_LAS bf16x8*)(lds + PG8_SB(b, h) + boff + n * 2048 + k * 1024); } while (0)
#define PG8_MMA(ai, bj, At, Bt) do { __builtin_amdgcn_s_setprio(1); _Pragma("unroll") for (int m = 0; m < 4; ++m) _Pragma("unroll") for (int n = 0; n < 2; ++n) _Pragma("unroll") for (int k = 0; k < 2; ++k) \
        acc[ai][bj][m][n] = __builtin_amdgcn_mfma_f32_16x16x32_bf16(Bt[n][k], At[m][k], acc[ai][bj][m][n], 0, 0, 0); __builtin_amdgcn_s_setprio(0); } while (0)
#define PG8_WAIT_V(n) asm volatile("s_waitcnt vmcnt(" #n ")" ::: "memory")
#define PG8_WAIT_L(n) asm volatile("s_waitcnt lgkmcnt(" #n ")" ::: "memory")
#define PG8_BAR __builtin_amdgcn_s_barrier()
#define PG8_SCHED __builtin_amdgcn_sched_barrier(0)
    Unit cur, nxt; int ui = 0;
    if (!S.next(0, cur)) return;
    f32x4 acc[2][2][4][2];
#pragma unroll
    for (int a = 0; a < 2; ++a)
#pragma unroll
        for (int b = 0; b < 2; ++b)
#pragma unroll
            for (int m = 0; m < 4; ++m)
#pragma unroll
                for (int n = 0; n < 2; ++n) acc[a][b][m][n] = (f32x4){0.f, 0.f, 0.f, 0.f};
    bf16x8 At[4][2], B0[2][2], B1[2][2];
    const char* cA = (const char*)g.A + (size_t)cur.pm * tstep; const char* cB = (const char*)g.Bt + (size_t)cur.pn * tstep;
    S.a_ready(cur);
    if constexpr (SP2) {
        PG8_STAGE(PG8_SB(0, 0), cB, voffB); PG8_STAGE(PG8_SB(0, 1), cB + hstep, voffB); PG8_STAGE(PG8_SA(0, 0), cA, voffA); PG8_STAGE(PG8_SA(0, 1), cA + hstep, voffA);
        if (wr == 1) PG8_BAR;
        PG8_WAIT_V(2); PG8_BAR;
        PG8_STAGE(PG8_SB(1, 0), cB + kstep, voffB); PG8_STAGE(PG8_SA(1, 0), cA + kstep, voffA); PG8_STAGE(PG8_SB(1, 1), cB + hstep + kstep, voffB);
        PG8_WAIT_V(6); PG8_BAR;
    } else {
        PG8_STAGE(PG8_SB(0, 0), cB, voffB); PG8_STAGE(PG8_SA(0, 0), cA, voffA); PG8_STAGE(PG8_SB(0, 1), cB + hstep, voffB); PG8_STAGE(PG8_SA(0, 1), cA + hstep, voffA);
        if (wr == 1) PG8_BAR;
        PG8_WAIT_V(4); PG8_BAR;
        PG8_STAGE(PG8_SB(1, 0), cB + kstep, voffB); PG8_STAGE(PG8_SA(1, 0), cA + kstep, voffA); PG8_STAGE(PG8_SB(1, 1), cB + hstep + kstep, voffB);
        PG8_WAIT_V(6); PG8_BAR;
    }
    for (;;) {
        const bool has_next = S.next(ui + 1, nxt);
        const char* nA = has_next ? (const char*)g.A + (size_t)nxt.pm * tstep : cA; const char* nB = has_next ? (const char*)g.Bt + (size_t)nxt.pn * tstep : cB;
        for (int t = 0; t < nt; t += 2) {
            const bool last = (t == nt - 2);
            const char* a1 = cA + (size_t)(t + 1) * kstep;
            const char* a2 = last ? nA : cA + (size_t)(t + 2) * kstep; const char* b2 = last ? nB : cB + (size_t)(t + 2) * kstep;
            const char* a3 = a2 + kstep; const char* b3 = b2 + kstep;
            if (last && has_next) S.a_ready(nxt);
            if constexpr (SP2) {
            PG8_LDB(B0, 0, 0); PG8_LDB(B1, 0, 1); PG8_SCHED; PG8_LDA(At, 0, 0); PG8_STAGE(PG8_SA(1, 1), a1 + hstep, voffA);
            PG8_WAIT_V(8); PG8_WAIT_L(0); PG8_BAR; PG8_MMA(0, 0, At, B0); PG8_MMA(0, 1, At, B1); PG8_BAR; PG8_SCHED;
            PG8_LDA(At, 0, 1); PG8_STAGE(PG8_SB(0, 0), b2, voffB); PG8_STAGE(PG8_SB(0, 1), b2 + hstep, voffB); PG8_STAGE(PG8_SA(0, 0), a2, voffA);
            PG8_WAIT_V(8); PG8_WAIT_L(0); PG8_BAR; PG8_MMA(1, 0, At, B0); PG8_MMA(1, 1, At, B1); PG8_BAR; PG8_SCHED;
            PG8_LDB(B0, 1, 0); PG8_LDB(B1, 1, 1); PG8_SCHED; PG8_LDA(At, 1, 0); PG8_STAGE(PG8_SA(0, 1), a2 + hstep, voffA);
            PG8_WAIT_V(8); PG8_WAIT_L(0); PG8_BAR; PG8_MMA(0, 0, At, B0); PG8_MMA(0, 1, At, B1); PG8_BAR; PG8_SCHED;
            PG8_LDA(At, 1, 1); PG8_STAGE(PG8_SB(1, 0), b3, voffB); PG8_STAGE(PG8_SB(1, 1), b3 + hstep, voffB); PG8_STAGE(PG8_SA(1, 0), a3, voffA);
            PG8_WAIT_V(8); PG8_WAIT_L(0); PG8_BAR; PG8_MMA(1, 0, At, B0); PG8_MMA(1, 1, At, B1); PG8_BAR; PG8_SCHED;
            } else {
            PG8_LDB(B0, 0, 0); PG8_SCHED; PG8_LDA(At, 0, 0); PG8_STAGE(PG8_SA(1, 1), a1 + hstep, voffA);
            PG8_WAIT_L(8); PG8_BAR; PG8_WAIT_L(0); PG8_MMA(0, 0, At, B0); PG8_BAR; PG8_SCHED;
            PG8_LDB(B1, 0, 1); PG8_STAGE(PG8_SB(0, 0), b2, voffB);
            PG8_BAR; PG8_WAIT_L(0); PG8_MMA(0, 1, At, B1); PG8_BAR;
            PG8_LDA(At, 0, 1); PG8_STAGE(PG8_SA(0, 0), a2, voffA);
            PG8_BAR; PG8_WAIT_L(0); PG8_MMA(1, 0, At, B0); PG8_BAR; PG8_SCHED;
            PG8_STAGE(PG8_SB(0, 1), b2 + hstep, voffB);
            PG8_WAIT_V(6); PG8_BAR; PG8_MMA(1, 1, At, B1); PG8_BAR;
            PG8_LDB(B0, 1, 0); PG8_SCHED; PG8_LDA(At, 1, 0); PG8_STAGE(PG8_SA(0, 1), a2 + hstep, voffA);
            PG8_WAIT_L(8); PG8_BAR; PG8_WAIT_L(0); PG8_MMA(0, 0, At, B0); PG8_BAR; PG8_SCHED;
            PG8_LDB(B1, 1, 1); PG8_STAGE(PG8_SB(1, 0), b3, voffB);
            PG8_BAR; PG8_WAIT_L(0); PG8_MMA(0, 1, At, B1); PG8_BAR;
            PG8_LDA(At, 1, 1); PG8_STAGE(PG8_SA(1, 0), a3, voffA);
            PG8_BAR; PG8_WAIT_L(0); PG8_MMA(1, 0, At, B0); PG8_BAR; PG8_SCHED;
            PG8_STAGE(PG8_SB(1, 1), b3 + hstep, voffB);
            PG8_WAIT_V(6); PG8_BAR; PG8_MMA(1, 1, At, B1); PG8_BAR;
            }
        }
        if constexpr (ALIGN_EPI) { if (wr == 0) PG8_BAR; }
        if constexpr (!Epi::AFTER_DRAIN) { E(acc, cur, wr, wc, fr, fq); S.done(cur); }
        if (!has_next) break;
#pragma unroll
        for (int a = 0; a < 2; ++a)
#pragma unroll
            for (int b = 0; b < 2; ++b)
#pragma unroll
                for (int m = 0; m < 4; ++m)
#pragma unroll
                    for (int n = 0; n < 2; ++n) acc[a][b][m][n] = (f32x4){0.f, 0.f, 0.f, 0.f};
        cur = nxt; cA = nA; cB = nB; ++ui;
        if constexpr (ALIGN_EPI) { if (wr == 1) PG8_BAR; }
    }
    PG8_WAIT_V(0);
    if constexpr (!ALIGN_EPI) { if (wr == 0) PG8_BAR; }
    PG8_BAR;
    if constexpr (Epi::AFTER_DRAIN) { E.fused(acc, cur, wr, wc, fr, fq, lds, wid, lane); S.done(cur); }
#undef PG8_SA
#undef PG8_SB
#undef PG8_STAGE
#undef PG8_LDA
#undef PG8_LDB
#undef PG8_MMA
#undef PG8_WAIT_V
#undef PG8_WAIT_L
#undef PG8_BAR
#undef PG8_SCHED
}
}

#define LAS __attribute__((address_space(3)))
typedef unsigned short bf16;
typedef unsigned u32x4 __attribute__((ext_vector_type(4)));
typedef unsigned u32x2 __attribute__((ext_vector_type(2)));
typedef float f32x4 __attribute__((ext_vector_type(4)));
typedef float f32x16 __attribute__((ext_vector_type(16)));
typedef short bf16x8 __attribute__((ext_vector_type(8)));

constexpr int TP = 32768, TV = 32896, TT = 33024;
constexpr int LR = 41216, LRV = 41088;
constexpr int SKV = 1040, KHS_T = 1104;
constexpr float EPS = 1e-6f;
constexpr float LOG2E = 1.4426950408889634f;
constexpr float SC_MLA = 0.10206207261596577f * LOG2E;
constexpr float SC_MEM = 0.08838834764831845f * LOG2E;

constexpr size_t al256(size_t x) { return (x + 255) & ~(size_t)255; }
constexpr size_t OFF_CTL = 0, CTL_BYTES = 16384;
constexpr size_t OFF_SS = CTL_BYTES;
constexpr size_t OFF_MSS = al256(OFF_SS + (size_t)6 * TT * 4);
constexpr size_t OFF_ROPE = al256(OFF_MSS + 1024 * 4);
constexpr size_t W_WIN = 0, W_WUQ = W_WIN + (size_t)1536 * 1024 * 2, W_WK = W_WUQ + (size_t)768 * 256 * 2, W_WVT = W_WK + (size_t)512 * 128 * 2,
                 W_WOUT = W_WVT + (size_t)512 * 128 * 2, W_WMQ = W_WOUT + (size_t)1024 * 1024 * 2, W_WMO = W_WMQ + (size_t)512 * 1024 * 2,
                 W_FF1 = W_WMO + (size_t)1024 * 512 * 2, W_FF2 = W_FF1 + (size_t)4096 * 1024 * 2, W_LAYER = W_FF2 + (size_t)1024 * 4096 * 2;
constexpr size_t OFF_W = al256(OFF_ROPE + (size_t)8192 * 16 * 8);
constexpr size_t OFF_WMKV = OFF_W + 2 * W_LAYER;
constexpr size_t OFF_MEMB = OFF_WMKV + (size_t)2048 * 1024 * 2;
constexpr size_t OFF_MKVRAW = OFF_MEMB + (size_t)1024 * 1024 * 2;
constexpr size_t OFF_MK = OFF_MKVRAW + (size_t)1024 * 2048 * 4;
constexpr size_t OFF_MVT = OFF_MK + (size_t)2 * 12 * 4 * 256 * 128 * 2;
constexpr size_t OFF_XB = OFF_MVT + (size_t)2 * 12 * 4 * 256 * 128 * 2;
constexpr size_t OFF_LATC = OFF_XB + (size_t)TT * 1024 * 2;
constexpr size_t OFF_KR = OFF_LATC + (size_t)LR * 128 * 2;
constexpr size_t OFF_UG = OFF_KR + (size_t)LR * 32 * 2;
constexpr size_t OFF_VG = OFF_UG + (size_t)TT * 256 * 2, OFF_Z = OFF_VG + (size_t)TT * 256 * 2, OFF_CQ = OFF_Z + (size_t)TT * 256 * 2;
constexpr size_t OFF_A = OFF_CQ + (size_t)TT * 256 * 2;
constexpr size_t SZ_A = (size_t)TT * 1536 * 2;
constexpr size_t OFF_H = OFF_A, OFF_QRAW = OFF_A, OFF_KRAW = OFF_A + (size_t)TT * 768 * 2, OFF_QMRAW = OFF_A, OFF_OM = OFF_A + (size_t)TT * 512 * 2;
static_assert((size_t)TT * 768 * 2 + (size_t)LR * 512 * 2 <= SZ_A, "region A");
constexpr size_t OFF_B = OFF_A + SZ_A;
constexpr size_t OFF_VT = OFF_B, OFF_KH = OFF_VT + (size_t)512 * LR * 2, OFF_KHS = OFF_KH + (size_t)32 * 8192 * 96 * 2;
constexpr size_t OFF_C = OFF_KHS + (size_t)64 * KHS_T * 96 * 2;
constexpr size_t OFF_MIX = OFF_C;
constexpr size_t OFF_HID = OFF_A;
constexpr size_t WS_END = OFF_MIX + (size_t)TT * 1024 * 2;
static_assert(OFF_HID + (size_t)TT * 4096 * 2 <= WS_END, "HID overlay");

constexpr size_t O_YP = 0, O_YS = 33554432, O_LATP = 33685504, O_KRP = 42074112, O_CONVP = 44171264, O_MKP = 44232704, O_MVP = 45281280,
                 O_LATS = 46329856, O_KRS = 46362624, O_CONVS = 46370816, O_GVS = 46493696, O_END = 46559232;

constexpr int LDS_BYTES = 147456;
constexpr int NPHASE = 23;

struct Params { const float* in[37]; float* out; unsigned char* ws; int ph_lo, ph_hi; };

__device__ __forceinline__ float bflo(unsigned w) { return __uint_as_float(w << 16); }
__device__ __forceinline__ float bfhi(unsigned w) { return __uint_as_float(w & 0xffff0000u); }
__device__ __forceinline__ unsigned pk2(float lo, float hi) {
    typedef float f2_t __attribute__((ext_vector_type(2))); typedef __bf16 b2_t __attribute__((ext_vector_type(2)));
    f2_t v = {lo, hi}; b2_t b = __builtin_convertvector(v, b2_t); return __builtin_bit_cast(unsigned, b);
}
template <int CTRL> __device__ __forceinline__ float dpp_add(float v) {
    return v + __builtin_bit_cast(float, __builtin_amdgcn_update_dpp(0, __builtin_bit_cast(int, v), CTRL, 0xf, 0xf, true));
}
__device__ __forceinline__ float sum4(float v) { v = dpp_add<0xB1>(v); return dpp_add<0x4E>(v); }
__device__ __forceinline__ float sum8(float v) { return dpp_add<0x141>(sum4(v)); }
__device__ __forceinline__ float sum16(float v) { return dpp_add<0x140>(sum8(v)); }
__device__ __forceinline__ float swap16_sum(float v) {
    auto rr = __builtin_amdgcn_permlane16_swap(__float_as_uint(v), __float_as_uint(v), false, false);
    return __uint_as_float(rr[0]) + __uint_as_float(rr[1]);
}
__device__ __forceinline__ float half_sum(float v);
__device__ __forceinline__ float wave_sum(float v) { return half_sum(swap16_sum(sum16(v))); }
__device__ __forceinline__ float half_sum(float v) {
    auto rr = __builtin_amdgcn_permlane32_swap(__float_as_uint(v), __float_as_uint(v), false, false);
    return __uint_as_float(rr[0]) + __uint_as_float(rr[1]);
}
__device__ __forceinline__ float half_max(float v) {
    auto rr = __builtin_amdgcn_permlane32_swap(__float_as_uint(v), __float_as_uint(v), false, false);
    return fmaxf(__uint_as_float(rr[0]), __uint_as_float(rr[1]));
}
__device__ __forceinline__ float gelu_f(float x) { return 0.5f * x * (1.0f + erff(x * 0.70710678118654752f)); }
__device__ __forceinline__ float sigm_f(float x) { return 1.0f / (1.0f + __expf(-x)); }

struct EpiU {
    static constexpr bool PERM = false, AFTER_DRAIN = false;
    int mode;
    int relu2;
    void* out; int ldc;
    const float* ss; float ssdiv;
    float* ssout;
    const float* base_p; const float* base_s; bf16* xb;
    const float* gkn; const bf16* kr; bf16* kh; bf16* khs;
    __device__ __forceinline__ void operator()(const pg8::f32x4 (&acc)[2][2][4][2], const pg8::Unit& u, int wr, int wc, int fr, int fq) const {
        const int row0 = u.pm * 256 + wr * 64 + fr, col0 = u.pn * 256 + wc * 32 + 4 * fq;
#pragma unroll
        for (int ai = 0; ai < 2; ++ai)
#pragma unroll
            for (int m = 0; m < 4; ++m) {
                const int row = row0 + ai * 128 + m * 16;
                const float rs = ss ? rsqrtf(ss[row] * ssdiv + EPS) : 1.0f;
#pragma unroll
                for (int bj = 0; bj < 2; ++bj)
#pragma unroll
                    for (int n = 0; n < 2; ++n) { const int c = col0 + bj * 128 + n * 16; *(f32x4*)((float*)out + (size_t)row * ldc + c) = acc[ai][bj][m][n] * rs; }
            }
    }
};

struct EpiP {
    static constexpr bool PERM = true, AFTER_DRAIN = false;
    int mode;
    int relu2; void* out; int ldc; const float* ss; float ssdiv; float* ssout; bf16* xb;
    const float* gkn; const bf16* kr; bf16* kh; bf16* khs;
    __device__ __forceinline__ void operator()(const pg8::f32x4 (&acc)[2][2][4][2], const pg8::Unit& u, int wr, int wc, int fr, int fq) const {
        const int row0 = u.pm * 256 + wr * 64 + fr, col0 = u.pn * 256 + wc * 32 + 8 * fq;
        if (mode == 0) {
            float rsv[2][4];
#pragma unroll
            for (int ai = 0; ai < 2; ++ai)
#pragma unroll
                for (int m = 0; m < 4; ++m) rsv[ai][m] = ss ? ss[row0 + ai * 128 + m * 16] : 0.f;
#pragma unroll
            for (int ai = 0; ai < 2; ++ai)
#pragma unroll
                for (int m = 0; m < 4; ++m) {
                    const int row = row0 + ai * 128 + m * 16;
                    const float rs = ss ? rsqrtf(rsv[ai][m] * ssdiv + EPS) : 1.0f;
                    bf16* rowp = (bf16*)out + (size_t)row * ldc + col0;
#pragma unroll
                    for (int bj = 0; bj < 2; ++bj) { f32x4 v0 = acc[ai][bj][m][0] * rs, v1 = acc[ai][bj][m][1] * rs;
                        if (relu2) { v0[0] = fmaxf(v0[0], 0.f); v0[1] = fmaxf(v0[1], 0.f); v0[2] = fmaxf(v0[2], 0.f); v0[3] = fmaxf(v0[3], 0.f); v0 = v0 * v0;
                                     v1[0] = fmaxf(v1[0], 0.f); v1[1] = fmaxf(v1[1], 0.f); v1[2] = fmaxf(v1[2], 0.f); v1[3] = fmaxf(v1[3], 0.f); v1 = v1 * v1; }
                        u32x4 w; w.x = pk2(v0[0], v0[1]); w.y = pk2(v0[2], v0[3]); w.z = pk2(v1[0], v1[1]); w.w = pk2(v1[2], v1[3]);
                        *(u32x4*)(rowp + bj * 128) = w; }
                }
        } else if (mode == 1) {
#pragma unroll
            for (int ai = 0; ai < 2; ++ai) {
                u32x4 bwv[4][2];
#pragma unroll
                for (int m = 0; m < 4; ++m)
#pragma unroll
                    for (int bj = 0; bj < 2; ++bj) bwv[m][bj] = *(const u32x4*)(xb + (size_t)(row0 + ai * 128 + m * 16) * 1024 + col0 + bj * 128);
#pragma unroll
                for (int m = 0; m < 4; ++m) {
                    const int row = row0 + ai * 128 + m * 16; float s2 = 0.f;
                    bf16* xp = xb + (size_t)row * 1024 + col0; float* op = (float*)out + (size_t)row * 1024 + col0;
#pragma unroll
                    for (int bj = 0; bj < 2; ++bj) { const u32x4 bw = bwv[m][bj];
                        const f32x4 x0 = (f32x4){bflo(bw.x), bfhi(bw.x), bflo(bw.y), bfhi(bw.y)} + acc[ai][bj][m][0], x1 = (f32x4){bflo(bw.z), bfhi(bw.z), bflo(bw.w), bfhi(bw.w)} + acc[ai][bj][m][1];
                        if (out) { *(f32x4*)(op + bj * 128) = x0; *(f32x4*)(op + bj * 128 + 4) = x1; }
                        else { u32x4 w; w.x = pk2(x0[0], x0[1]); w.y = pk2(x0[2], x0[3]); w.z = pk2(x1[0], x1[1]); w.w = pk2(x1[2], x1[3]); *(u32x4*)(xp + bj * 128) = w; }
                        s2 += ((x0[0] * x0[0] + x0[1] * x0[1]) + (x0[2] * x0[2] + x0[3] * x0[3])) + ((x1[0] * x1[0] + x1[1] * x1[1]) + (x1[2] * x1[2] + x1[3] * x1[3])); }
                    s2 = half_sum(swap16_sum(s2));
                    if (fq == 0) unsafeAtomicAdd(ssout + row, s2);
                }
            }
        } else {
            const int hh = 4 * u.pn + wc;
            f32x4 gv[2][2];
#pragma unroll
            for (int bj = 0; bj < 2; ++bj)
#pragma unroll
                for (int n = 0; n < 2; ++n) gv[bj][n] = *(const f32x4*)(gkn + 32 * bj + 8 * fq + 4 * n);
            u32x4 krv[2][4];
#pragma unroll
            for (int ai = 0; ai < 2; ++ai)
#pragma unroll
                for (int m = 0; m < 4; ++m) { const int r = row0 + ai * 128 + m * 16; krv[ai][m] = *(const u32x4*)(kr + (size_t)(r < LRV ? r : 0) * 32 + 8 * fq); }
#pragma unroll
            for (int ai = 0; ai < 2; ++ai)
#pragma unroll
                for (int m = 0; m < 4; ++m) {
                    const int r = row0 + ai * 128 + m * 16; float s2 = 0.f;
#pragma unroll
                    for (int bj = 0; bj < 2; ++bj)
#pragma unroll
                        for (int n = 0; n < 2; ++n) { const f32x4 x = acc[ai][bj][m][n]; s2 += (x[0] * x[0] + x[1] * x[1]) + (x[2] * x[2] + x[3] * x[3]); }
                    s2 = half_sum(swap16_sum(s2));
                    const float rs = rsqrtf(s2 * (1.0f / 64.0f) + EPS);
                    if (r < LRV) {
                        bf16* dst;
                        if (r < TP) { const int b = r >> 13, t = r & 8191; dst = kh + ((size_t)(b * 8 + hh) * 8192 + t) * 96; }
                        else { const int rr = r - TP, b = rr / SKV, t = rr - b * SKV; dst = khs + ((size_t)(b * 8 + hh) * KHS_T + t) * 96; }
#pragma unroll
                        for (int bj = 0; bj < 2; ++bj) { const f32x4 v0 = acc[ai][bj][m][0] * rs * gv[bj][0], v1 = acc[ai][bj][m][1] * rs * gv[bj][1];
                            u32x4 w; w.x = pk2(v0[0], v0[1]); w.y = pk2(v0[2], v0[3]); w.z = pk2(v1[0], v1[1]); w.w = pk2(v1[2], v1[3]);
                            *(u32x4*)(dst + 32 * bj + 8 * fq) = w; }
                        *(u32x4*)(dst + 64 + 8 * fq) = krv[ai][m];
                    }
                }
        }
    }
};

#define MFMA32(a, b, c) __builtin_amdgcn_mfma_f32_32x32x16_bf16((a), (b), (c), 0, 0, 0)
template <int KSTR, int VSTR> struct SrcLds {
    const LAS char* k; const LAS char* v;
    __device__ __forceinline__ bf16x8 kfrag(int hf, int s) const { return *(const LAS bf16x8*)(k + hf * 32 * KSTR + s * 32); }
    __device__ __forceinline__ bf16x8 vfrag(int dd, int hf, int s2) const { return *(const LAS bf16x8*)(v + dd * 32 * VSTR + hf * 64 + s2 * 32); }
};
#define MX3(a, b, c) __builtin_fmaxf(__builtin_fmaxf((a), (b)), (c))
template <int NS, int ND, class Src>
__device__ __forceinline__ void attn_tile(const bf16x8 (&q)[NS], f32x16 (&o)[ND], bool& shifted, float& m, float& l, const Src& src, int kvalid, int hi) {
    f32x16 z;
#pragma unroll
    for (int r = 0; r < 16; ++r) z[r] = 0.f;
    constexpr bool BATCH = (NS == 6);
    f32x16 p0, p1; bf16x8 vfa[ND][2];
    if constexpr (BATCH) {
        bf16x8 k0[NS], k1[NS];
#pragma unroll
        for (int s = 0; s < NS; ++s) { k0[s] = src.kfrag(0, s); k1[s] = src.kfrag(1, s); }
        __builtin_amdgcn_sched_barrier(0);
        p0 = MFMA32(k0[0], q[0], z); p1 = MFMA32(k1[0], q[0], z);
#pragma unroll
        for (int s = 1; s < NS; ++s) { p0 = MFMA32(k0[s], q[s], p0); p1 = MFMA32(k1[s], q[s], p1); }
#pragma unroll
        for (int dd = 0; dd < ND; ++dd) { vfa[dd][0] = src.vfrag(dd, 0, 0); vfa[dd][1] = src.vfrag(dd, 0, 1); }
        __builtin_amdgcn_sched_barrier(0);
    } else {
        { bf16x8 kk[NS];
#pragma unroll
          for (int s = 0; s < NS; ++s) kk[s] = src.kfrag(0, s);
          __builtin_amdgcn_sched_barrier(0);
          p0 = MFMA32(kk[0], q[0], z);
#pragma unroll
          for (int s = 1; s < NS; ++s) p0 = MFMA32(kk[s], q[s], p0); }
        __builtin_amdgcn_sched_barrier(0);
        { bf16x8 kk[NS];
#pragma unroll
          for (int s = 0; s < NS; ++s) kk[s] = src.kfrag(1, s);
          __builtin_amdgcn_sched_barrier(0);
          p1 = MFMA32(kk[0], q[0], z);
#pragma unroll
          for (int s = 1; s < NS; ++s) p1 = MFMA32(kk[s], q[s], p1); }
        __builtin_amdgcn_sched_barrier(0);
    }
    if (kvalid < 64) {
#pragma unroll
        for (int r = 0; r < 16; ++r) { const int kv = 16 * (r >> 3) + 8 * hi + (r & 7); if (kv >= kvalid) p0[r] = -INFINITY; if (kv + 32 >= kvalid) p1[r] = -INFINITY; }
    }
    float ma = MX3(p0[0], p0[1], p1[0]), mb = MX3(p0[2], p0[3], p1[1]); ma = MX3(ma, p1[2], p1[3]);
#pragma unroll
    for (int r = 4; r < 16; r += 4) { ma = MX3(ma, p0[r], p0[r + 1]); mb = MX3(mb, p0[r + 2], p0[r + 3]); ma = MX3(ma, p1[r], p1[r + 1]); mb = MX3(mb, p1[r + 2], p1[r + 3]); }
    const float mx = half_max(fmaxf(ma, mb)) - m;
    if (__any(fabsf(mx) > 8.0f)) {
        const float dl = fabsf(mx) > 8.0f ? mx : 0.0f; m += dl;
        const float f = __builtin_amdgcn_exp2f(-dl); l *= f;
#pragma unroll
        for (int dd = 0; dd < ND; ++dd) o[dd] = o[dd] * f;
        shifted = __any(m != 0.0f);
    }
    if (shifted) {
#pragma unroll
        for (int r = 0; r < 16; ++r) { p0[r] -= m; p1[r] -= m; }
    }
    float sum = 0.f; bf16x8 pb0, pb1;
#pragma unroll
    for (int r = 0; r < 16; ++r) { p0[r] = __builtin_amdgcn_exp2f(p0[r]); sum += p0[r]; }
    { u32x4 w; w.x = pk2(p0[0], p0[1]); w.y = pk2(p0[2], p0[3]); w.z = pk2(p0[4], p0[5]); w.w = pk2(p0[6], p0[7]); pb0 = __builtin_bit_cast(bf16x8, w);
      w.x = pk2(p0[8], p0[9]); w.y = pk2(p0[10], p0[11]); w.z = pk2(p0[12], p0[13]); w.w = pk2(p0[14], p0[15]); pb1 = __builtin_bit_cast(bf16x8, w); }
    bf16x8 vfb[ND][2];
    if constexpr (BATCH) {
#pragma unroll
        for (int dd = 0; dd < ND; ++dd) { vfb[dd][0] = src.vfrag(dd, 1, 0); vfb[dd][1] = src.vfrag(dd, 1, 1); }
        __builtin_amdgcn_sched_barrier(0);
#pragma unroll
        for (int dd = 0; dd < ND; ++dd) { o[dd] = MFMA32(vfa[dd][0], pb0, o[dd]); o[dd] = MFMA32(vfa[dd][1], pb1, o[dd]); }
    } else {
#pragma unroll
        for (int dd = 0; dd < ND; ++dd) { vfa[dd][0] = src.vfrag(dd, 0, 0); vfa[dd][1] = src.vfrag(dd, 0, 1); }
        __builtin_amdgcn_sched_barrier(0);
#pragma unroll
        for (int dd = 0; dd < ND; ++dd) { o[dd] = MFMA32(vfa[dd][0], pb0, o[dd]); o[dd] = MFMA32(vfa[dd][1], pb1, o[dd]); }
        __builtin_amdgcn_sched_barrier(0);
    }
#pragma unroll
    for (int r = 0; r < 16; ++r) { p1[r] = __builtin_amdgcn_exp2f(p1[r]); sum += p1[r]; }
    { u32x4 w; w.x = pk2(p1[0], p1[1]); w.y = pk2(p1[2], p1[3]); w.z = pk2(p1[4], p1[5]); w.w = pk2(p1[6], p1[7]); pb0 = __builtin_bit_cast(bf16x8, w);
      w.x = pk2(p1[8], p1[9]); w.y = pk2(p1[10], p1[11]); w.z = pk2(p1[12], p1[13]); w.w = pk2(p1[14], p1[15]); pb1 = __builtin_bit_cast(bf16x8, w); }
    if constexpr (!BATCH) {
#pragma unroll
        for (int dd = 0; dd < ND; ++dd) { vfa[dd][0] = src.vfrag(dd, 1, 0); vfa[dd][1] = src.vfrag(dd, 1, 1); }
        __builtin_amdgcn_sched_barrier(0);
    }
#pragma unroll
    for (int dd = 0; dd < ND; ++dd) { if constexpr (BATCH) { o[dd] = MFMA32(vfb[dd][0], pb0, o[dd]); o[dd] = MFMA32(vfb[dd][1], pb1, o[dd]); }
                                      else { o[dd] = MFMA32(vfa[dd][0], pb0, o[dd]); o[dd] = MFMA32(vfa[dd][1], pb1, o[dd]); } }
    l += sum;
}

template <int DQK, int DV>
__device__ __forceinline__ void attn_block(LAS char* lds, const bf16x8 (&q)[DQK / 16], const bf16* Kg, const bf16* Vg, int vstride, int ntile, int mynt, int kvlen,
                                           f32x16 (&o)[DV / 32], float& lsum) {
    constexpr int NS = DQK / 16, ND = DV / 32, KSTR = DQK * 2 + 16, VSTR = 144, KB = 64 * KSTR, VB = DV * VSTR, BUF = KB + VB;
    constexpr int KCH = DQK / 8, NKC = 64 * KCH, NVI = DV / 64;
    int tid = threadIdx.x; asm volatile("" : "+v"(tid));
    const int lane = tid & 63, r32 = lane & 31, hi = lane >> 5;
    const int rowsw = (r32 & 0x13) | ((r32 & 4) << 1) | ((r32 & 8) >> 1);
    const int kc0 = tid, kc1 = tid + 512; const bool k1v = kc1 < NKC;
    typedef __attribute__((address_space(1))) const char gcc_t;
    gcc_t* Kgb = (gcc_t*)Kg; gcc_t* Vgb = (gcc_t*)Vg;
    const unsigned ko0 = (unsigned)((kc0 / KCH) * DQK + (kc0 % KCH) * 8) * 2u; const int kl0 = (kc0 / KCH) * KSTR + (kc0 % KCH) * 16;
    const unsigned ko1 = (unsigned)((kc1 / KCH) * DQK + (kc1 % KCH) * 8) * 2u; const int kl1 = (kc1 / KCH) * KSTR + (kc1 % KCH) * 16;
    unsigned vo[NVI]; int vl[NVI];
#pragma unroll
    for (int i = 0; i < NVI; ++i) { const int c = tid + 512 * i, d = c >> 3, vc = c & 7; vo[i] = (unsigned)(d * vstride + vc * 8) * 2u; vl[i] = KB + d * VSTR + vc * 16; }
    u32x4 kreg0, kreg1 = {0u, 0u, 0u, 0u}, vreg[NVI];
#define ATT_LOAD(t) do { gcc_t* kt_ = Kgb + (size_t)(t) * 64 * DQK * 2; gcc_t* vt_ = Vgb + (size_t)(t) * 128; \
        kreg0 = *(const __attribute__((address_space(1))) u32x4*)(kt_ + ko0); if (k1v) kreg1 = *(const __attribute__((address_space(1))) u32x4*)(kt_ + ko1); \
        _Pragma("unroll") for (int i_ = 0; i_ < NVI; ++i_) vreg[i_] = *(const __attribute__((address_space(1))) u32x4*)(vt_ + vo[i_]); } while (0)
#define ATT_STORE(bo) do { *(LAS u32x4*)(lds + (bo) + kl0) = kreg0; if (k1v) *(LAS u32x4*)(lds + (bo) + kl1) = kreg1; \
        _Pragma("unroll") for (int i_ = 0; i_ < NVI; ++i_) *(LAS u32x4*)(lds + (bo) + vl[i_]) = vreg[i_]; } while (0)
    ATT_LOAD(0); ATT_STORE(0); __syncthreads();
    float m = 0.f, l = 0.f; bool shifted = false;
#pragma unroll
    for (int dd = 0; dd < ND; ++dd)
#pragma unroll
        for (int r = 0; r < 16; ++r) o[dd][r] = 0.f;
    for (int t = 0; t < ntile; ++t) {
        const int cur = (t & 1) * BUF;
        if (t + 1 < ntile) ATT_LOAD(t + 1);
        if (t < mynt) { SrcLds<KSTR, VSTR> src{lds + cur + rowsw * KSTR + hi * 16, lds + cur + KB + r32 * VSTR + hi * 16}; attn_tile<NS, ND>(q, o, shifted, m, l, src, min(64, kvlen - 64 * t), hi); }
        if (t + 1 < ntile) ATT_STORE(((t + 1) & 1) * BUF);
        __syncthreads();
    }
#undef ATT_LOAD
#undef ATT_STORE
    lsum = half_sum(l);
}
template <int ND>
__device__ __forceinline__ void attn_store(const f32x16 (&o)[ND], float lsum, bf16* orow, int hi, bool valid) {
    const float inv = 1.0f / lsum;
    if (valid) {
#pragma unroll
        for (int dd = 0; dd < ND; ++dd)
#pragma unroll
            for (int rg = 0; rg < 4; ++rg) { u32x2 w; w.x = pk2(o[dd][4 * rg] * inv, o[dd][4 * rg + 1] * inv); w.y = pk2(o[dd][4 * rg + 2] * inv, o[dd][4 * rg + 3] * inv);
                *(u32x2*)(orow + 32 * dd + 8 * rg + 4 * hi) = w; }
    }
}
__device__ __forceinline__ void load_q_mla(bf16x8 (&q)[6], const bf16* qp  , int hi, const float* gqn, const float* gqr, const float* ropep  ) {
    u32x4 raw[6];
#pragma unroll
    for (int s = 0; s < 6; ++s) raw[s] = *(const u32x4*)(qp + 16 * s + 8 * hi);
    float x[6][8];
#pragma unroll
    for (int s = 0; s < 6; ++s) { x[s][0] = bflo(raw[s].x); x[s][1] = bfhi(raw[s].x); x[s][2] = bflo(raw[s].y); x[s][3] = bfhi(raw[s].y);
        x[s][4] = bflo(raw[s].z); x[s][5] = bfhi(raw[s].z); x[s][6] = bflo(raw[s].w); x[s][7] = bfhi(raw[s].w); }
    float ss = 0.f, sr = 0.f;
#pragma unroll
    for (int s = 0; s < 4; ++s)
#pragma unroll
        for (int j = 0; j < 8; ++j) ss += x[s][j] * x[s][j];
#pragma unroll
    for (int j = 0; j < 8; ++j) sr += x[4][j] * x[4][j] + x[5][j] * x[5][j];
    ss = half_sum(ss); sr = half_sum(sr);
    const float rs = rsqrtf(ss * (1.0f / 64.0f) + EPS) * SC_MLA, rr = rsqrtf(sr * (1.0f / 32.0f) + EPS);
#pragma unroll
    for (int s = 0; s < 4; ++s)
#pragma unroll
        for (int j = 0; j < 8; ++j) x[s][j] *= rs * gqn[16 * s + 8 * hi + j];
#pragma unroll
    for (int j = 0; j < 8; ++j) { const int i = 8 * hi + j; const float a1 = x[4][j] * rr * gqr[i], a2 = x[5][j] * rr * gqr[16 + i];
        const float c = ropep[2 * i], sn = ropep[2 * i + 1]; x[4][j] = (a1 * c - a2 * sn) * SC_MLA; x[5][j] = (a1 * sn + a2 * c) * SC_MLA; }
#pragma unroll
    for (int s = 0; s < 6; ++s) { u32x4 w; w.x = pk2(x[s][0], x[s][1]); w.y = pk2(x[s][2], x[s][3]); w.z = pk2(x[s][4], x[s][5]); w.w = pk2(x[s][6], x[s][7]); q[s] = __builtin_bit_cast(bf16x8, w); }
}
__device__ __forceinline__ void load_q_mem(bf16x8 (&q)[8], const bf16* qp  , int hi, const float* gq) {
    u32x4 raw[8];
#pragma unroll
    for (int s = 0; s < 8; ++s) raw[s] = *(const u32x4*)(qp + 16 * s + 8 * hi);
    float ss = 0.f;
#pragma unroll
    for (int s = 0; s < 8; ++s) { const float a0 = bflo(raw[s].x), a1 = bfhi(raw[s].x), a2 = bflo(raw[s].y), a3 = bfhi(raw[s].y), a4 = bflo(raw[s].z), a5 = bfhi(raw[s].z), a6 = bflo(raw[s].w), a7 = bfhi(raw[s].w);
        ss += (a0 * a0 + a1 * a1) + (a2 * a2 + a3 * a3) + (a4 * a4 + a5 * a5) + (a6 * a6 + a7 * a7); }
    ss = half_sum(ss);
    const float rs = rsqrtf(ss * (1.0f / 128.0f) + EPS) * SC_MEM;
#pragma unroll
    for (int s = 0; s < 8; ++s) { const float* g = gq + 16 * s + 8 * hi; u32x4 w;
        w.x = pk2(bflo(raw[s].x) * rs * g[0], bfhi(raw[s].x) * rs * g[1]); w.y = pk2(bflo(raw[s].y) * rs * g[2], bfhi(raw[s].y) * rs * g[3]);
        w.z = pk2(bflo(raw[s].z) * rs * g[4], bfhi(raw[s].z) * rs * g[5]); w.w = pk2(bflo(raw[s].w) * rs * g[6], bfhi(raw[s].w) * rs * g[7]);
        q[s] = __builtin_bit_cast(bf16x8, w); }
}

__device__ __forceinline__ void skinny_gemm(const bf16* A  , const bf16* Bt, int N, int K, const EpiU& E, int gw, int NGW, int lane) {
    const int nwu = N >> 1; const int fr = lane & 15, fq = lane >> 4;
#pragma unroll 1
    for (int wu = gw; wu < nwu; wu += NGW) {
        const int rb = wu & 7, cb = wu >> 3;
        const bf16* ap = A + (size_t)(16 * rb + fr) * K + 8 * fq; const bf16* bp = Bt + (size_t)(16 * cb + fr) * K + 8 * fq;
        pg8::f32x4 acc = {0.f, 0.f, 0.f, 0.f};
        if ((K & 511) == 0) {
#pragma unroll 1
            for (int k0 = 0; k0 < K; k0 += 512) {
                bf16x8 a[16], w[16];
#pragma unroll
                for (int i = 0; i < 16; ++i) { a[i] = *(const bf16x8*)(ap + k0 + 32 * i); w[i] = *(const bf16x8*)(bp + k0 + 32 * i); }
                __builtin_amdgcn_sched_barrier(0);
#pragma unroll
                for (int i = 0; i < 16; ++i) acc = __builtin_amdgcn_mfma_f32_16x16x32_bf16(w[i], a[i], acc, 0, 0, 0);
                __builtin_amdgcn_sched_barrier(0);
            }
        } else {
#pragma unroll 1
            for (int k0 = 0; k0 < K; k0 += 256) {
                bf16x8 a[8], w[8];
#pragma unroll
                for (int i = 0; i < 8; ++i) { a[i] = *(const bf16x8*)(ap + k0 + 32 * i); w[i] = *(const bf16x8*)(bp + k0 + 32 * i); }
                __builtin_amdgcn_sched_barrier(0);
#pragma unroll
                for (int i = 0; i < 8; ++i) acc = __builtin_amdgcn_mfma_f32_16x16x32_bf16(w[i], a[i], acc, 0, 0, 0);
                __builtin_amdgcn_sched_barrier(0);
            }
        }
        const int row = TP + 16 * rb + fr, col = 16 * cb + 4 * fq;
        if (E.mode == 1) {
            bf16* xp = E.xb + (size_t)row * 1024 + col; const u32x2 bw = *(const u32x2*)xp; const f32x4 bs = {bflo(bw.x), bfhi(bw.x), bflo(bw.y), bfhi(bw.y)}; const f32x4 x = bs + acc;
            if (E.out) *(f32x4*)((float*)E.out + (size_t)row * 1024 + col) = x; else { u32x2 wv; wv.x = pk2(x[0], x[1]); wv.y = pk2(x[2], x[3]); *(u32x2*)xp = wv; }
            float s2 = (x[0] * x[0] + x[1] * x[1]) + (x[2] * x[2] + x[3] * x[3]);
            s2 = half_sum(swap16_sum(s2));
            if (fq == 0) unsafeAtomicAdd(E.ssout + row, s2);
        } else {
            const float rs = E.ss ? rsqrtf(E.ss[row] * E.ssdiv + EPS) : 1.0f; f32x4 v = acc * rs;
            if (E.relu2) { v[0] = fmaxf(v[0], 0.f); v[1] = fmaxf(v[1], 0.f); v[2] = fmaxf(v[2], 0.f); v[3] = fmaxf(v[3], 0.f); v = v * v; }
            u32x2 wv; wv.x = pk2(v[0], v[1]); wv.y = pk2(v[2], v[3]); *(u32x2*)((bf16*)E.out + (size_t)row * E.ldc + col) = wv;
        }
    }
}

__device__ __forceinline__ void conv_w(const float* W, int Nsrc, int K, int ndst, int blk, int sblk, int soff, const float* gain, bf16* dst, LAS float* scr, int gw, int NGW, int lane) {
    const int nblk = ndst / 32, nitems = (K / 64) * nblk;
#pragma unroll 1
    for (int it = gw; it < nitems; it += NGW) {
        const int kb = it / nblk, nb = it % nblk, k0 = 64 * kb, n0 = 32 * nb;
        const int sc0 = blk > 0 ? (n0 / blk) * sblk + soff + (n0 % blk)
                                : (((nb >> 3) * 4 + (nb & 3)) * 128 + 32 * ((nb >> 2) & 1));
        float wv[32];
#pragma unroll
        for (int i = 0; i < 32; ++i) wv[i] = W[(size_t)(k0 + 2 * i + (lane >> 5)) * Nsrc + sc0 + (lane & 31)];
        if (gain) {
#pragma unroll
            for (int i = 0; i < 32; ++i) wv[i] *= gain[k0 + 2 * i + (lane >> 5)];
        }
#pragma unroll
        for (int i = 0; i < 32; ++i) scr[(2 * i + (lane >> 5)) * 33 + (lane & 31)] = wv[i];
        asm volatile("s_waitcnt lgkmcnt(0)" ::: "memory");
        const int c = lane & 7;
#pragma unroll
        for (int j = 0; j < 4; ++j) { const int n = (lane >> 3) + 8 * j; const LAS float* s = scr + (8 * c) * 33 + n;
            u32x4 o; o.x = pk2(s[0 * 33], s[1 * 33]); o.y = pk2(s[2 * 33], s[3 * 33]); o.z = pk2(s[4 * 33], s[5 * 33]); o.w = pk2(s[6 * 33], s[7 * 33]);
            *(u32x4*)(dst + (size_t)(n0 + n) * K + k0 + 8 * c) = o; }
        asm volatile("s_waitcnt lgkmcnt(0)" ::: "memory");
    }
}
__device__ __forceinline__ float row_to_bf16(const float* xr, bf16* orow, int lane) {
    f32x4 v[4]; float s = 0.f;
#pragma unroll
    for (int j = 0; j < 4; ++j) { v[j] = ((const f32x4*)xr)[lane + 64 * j]; s += (v[j][0] * v[j][0] + v[j][1] * v[j][1]) + (v[j][2] * v[j][2] + v[j][3] * v[j][3]); }
#pragma unroll
    for (int j = 0; j < 4; ++j) { u32x2 w; w.x = pk2(v[j][0], v[j][1]); w.y = pk2(v[j][2], v[j][3]); ((u32x2*)orow)[lane + 64 * j] = w; }
    return wave_sum(s);
}

#define RLX_AGENT __ATOMIC_RELAXED, __HIP_MEMORY_SCOPE_AGENT
#define XB_TMO      128
#define XB_XCNT(j)  (256  + 64 * (j))
#define XB_XSUB(j)  (1280 + 64 * (j))
#define XB_XGEN(j)  (2304 + 64 * (j))
#define XB_TOP      3328
#define XB_TOPGEN   3392
#define XCD_BAR_WORDS 3456
#define XB_SPIN_CAP (1u << 18)

__device__ __forceinline__ unsigned xb_ld(unsigned* p)              { return __hip_atomic_load(p, __ATOMIC_RELAXED, __HIP_MEMORY_SCOPE_AGENT); }
__device__ __forceinline__ unsigned xb_add(unsigned* p, unsigned v) { return __hip_atomic_fetch_add(p, v, __ATOMIC_RELAXED, __HIP_MEMORY_SCOPE_AGENT); }
__device__ __forceinline__ unsigned xb_xcc_id() { return (unsigned)__builtin_amdgcn_s_getreg((3 << 11) | 20) & 0xFu; }
#define XB_SPIN(cond, bar) do { unsigned _sp = 0; while (cond) { __builtin_amdgcn_s_sleep(1); \
    if ((++_sp & 255u) == 0u) { if (xb_ld(&(bar)[XB_TMO])) break; if (_sp > XB_SPIN_CAP) { atomicAdd(&(bar)[XB_TMO], 1u); break; } } } } while (0)

struct XcdBarrier {
    unsigned* bar; unsigned x;
    volatile LAS unsigned* st;
};

__device__ __forceinline__ XcdBarrier xcd_barrier_post(unsigned* bar, volatile LAS unsigned* st) {
    XcdBarrier b; b.bar = bar; b.x = xb_xcc_id(); b.st = st;
    if (threadIdx.x == 0) (void)xb_add(&bar[XB_XCNT(b.x)], 1u);
    return b;
}
__device__ __forceinline__ void xcd_barrier_complete(unsigned* bar, unsigned x, unsigned& nloc, unsigned& nx) {
    const unsigned G = gridDim.x * gridDim.y * gridDim.z;
    unsigned sum, cnt, mine, sp = 0u;
    for (;;) {
        sum = 0u; cnt = 0u; mine = 0u;
#pragma unroll
        for (unsigned j = 0; j < 16; ++j) { const unsigned c = xb_ld(&bar[XB_XCNT(j)]); sum += c; cnt += (c > 0u) ? 1u : 0u; mine = (j == x) ? c : mine; }
        if (sum == G) break;
        __builtin_amdgcn_s_sleep(1);
        if ((++sp & 255u) == 0u) { if (xb_ld(&bar[XB_TMO])) break; if (sp > XB_SPIN_CAP) { atomicAdd(&bar[XB_TMO], 1u); break; } }
    }
    nloc = mine > 0u ? mine : 1u; nx = cnt > 0u ? cnt : 1u;
}

__device__ __forceinline__ void xcd_barrier(const XcdBarrier& b) {
    asm volatile("s_waitcnt vmcnt(0)" ::: "memory");
    __syncthreads();
    if (threadIdx.x == 0) {
        unsigned* bar = b.bar;
        __builtin_amdgcn_s_waitcnt(0);
        unsigned nloc = b.st[0], nx = b.st[1];
        if (nloc == 0u) { xcd_barrier_complete(bar, b.x, nloc, nx); b.st[0] = nloc; b.st[1] = nx; }
        const unsigned old = xb_add(&bar[XB_XSUB(b.x)], 1u);
        const unsigned gen = old / nloc;
        if (old + 1u == (gen + 1u) * nloc) {
            __builtin_amdgcn_fence(__ATOMIC_RELEASE, "agent");
            asm volatile("s_waitcnt vmcnt(0)" ::: "memory");
            const unsigned og = xb_add(&bar[XB_TOP], 1u);
            const unsigned tg = og / nx;
            if (og + 1u == (tg + 1u) * nx) xb_add(&bar[XB_TOPGEN], 1u);
            else XB_SPIN(xb_ld(&bar[XB_TOPGEN]) == tg, bar);
            __builtin_amdgcn_fence(__ATOMIC_ACQUIRE, "agent");
            xb_add(&bar[XB_XGEN(b.x)], 1u);
            asm volatile("s_waitcnt vmcnt(0)" ::: "memory");
        } else {
            XB_SPIN(xb_ld(&bar[XB_XGEN(b.x)]) == gen, bar);
            __builtin_amdgcn_fence(__ATOMIC_ACQUIRE, "agent");
            asm volatile("s_waitcnt vmcnt(0)" ::: "memory");
        }
    }
    __syncthreads();
}


#define SS ((float*)(ws + OFF_SS))
#define MSS ((float*)(ws + OFF_MSS))
#define ROPE ((float*)(ws + OFF_ROPE))
#define WMKV ((bf16*)(ws + OFF_WMKV))
#define MEMB ((bf16*)(ws + OFF_MEMB))
#define MKVRAW ((float*)(ws + OFF_MKVRAW))
#define MK ((bf16*)(ws + OFF_MK))
#define MVT ((bf16*)(ws + OFF_MVT))
#define XB ((bf16*)(ws + OFF_XB))
#define LATC ((bf16*)(ws + OFF_LATC))
#define KR ((bf16*)(ws + OFF_KR))
#define UG ((bf16*)(ws + OFF_UG))
#define VG ((bf16*)(ws + OFF_VG))
#define Zb ((bf16*)(ws + OFF_Z))
#define CQ ((bf16*)(ws + OFF_CQ))
#define Hb ((bf16*)(ws + OFF_H))
#define QRAW ((bf16*)(ws + OFF_QRAW))
#define KRAW ((bf16*)(ws + OFF_KRAW))
#define QMRAW ((bf16*)(ws + OFF_QMRAW))
#define OM ((bf16*)(ws + OFF_OM))
#define VT ((bf16*)(ws + OFF_VT))
#define KH ((bf16*)(ws + OFF_KH))
#define KHS ((bf16*)(ws + OFF_KHS))
#define MIX ((bf16*)(ws + OFF_MIX))
#define HID ((bf16*)(ws + OFF_HID))
#ifndef EN_PRO
#define EN_PRO 1
#endif
#ifndef EN_GEMM
#define EN_GEMM 1
#endif
#ifndef EN_E1
#define EN_E1 1
#endif
#ifndef EN_E2
#define EN_E2 1
#endif
#ifndef EN_KB
#define EN_KB 1
#endif
#ifndef EN_ATT
#define EN_ATT 1
#endif
#ifndef EN_MATT
#define EN_MATT 1
#endif
__global__ void __launch_bounds__(512, 2) fwd_kernel(Params P) {
    extern __shared__ __attribute__((aligned(16))) unsigned char lds_raw[];
    LAS unsigned char* lds = (LAS unsigned char*)lds_raw;
    LAS char* ldc_ = (LAS char*)lds_raw;
    const int G = gridDim.x;
    float* dout = P.out;
    cg::grid_group grid = cg::this_grid();
    volatile LAS unsigned* MISC = (volatile LAS unsigned*)(lds + 131072 + 320);
    if (threadIdx.x < 32) MISC[threadIdx.x] = 0u;
    __syncthreads();
    XcdBarrier bar; bar.bar = (unsigned*)(P.ws + OFF_CTL); bar.x = 0; bar.st = MISC + 8;
    if (P.ph_hi - P.ph_lo > 1) bar = xcd_barrier_post((unsigned*)(P.ws + OFF_CTL), MISC + 8);

#ifndef REPEAT_SP
#define REPEAT_SP 0
#endif
#ifndef DOUBLE_SYNC
#define DOUBLE_SYNC 0
#endif
    int redone = 0; (void)redone;
#pragma unroll 1
    for (int ph = P.ph_lo; ph < P.ph_hi; ++ph) {
        int bid = blockIdx.x; asm volatile("" : "+s"(bid));
        unsigned char* ws = P.ws; asm volatile("" : "+s"(ws));
        const int NGW = G * 8, GT = G * 512;
#define PHASE_IDS int tid = threadIdx.x; asm volatile("" : "+v"(tid)); const int lane = tid & 63, wid = __builtin_amdgcn_readfirstlane(tid >> 6); const int gw = bid * 8 + wid, gtid = bid * 512 + tid; (void)gw; (void)gtid; (void)lane;
        const int l = (ph - 1) / 11, sp = (ph == 0) ? 0 : ((ph - 1) % 11) + 1;
        if (sp == 4 && !(REPEAT_SP == 4)) continue;
        unsigned char* wl = ws + OFF_W + (size_t)l * W_LAYER;
#define WIN ((bf16*)(wl + W_WIN))
#define WUQ ((bf16*)(wl + W_WUQ))
#define WK ((bf16*)(wl + W_WK))
#define WVT ((bf16*)(wl + W_WVT))
#define WOUT ((bf16*)(wl + W_WOUT))
#define WMQ ((bf16*)(wl + W_WMQ))
#define WMO ((bf16*)(wl + W_WMO))
#define WFF1 ((bf16*)(wl + W_FF1))
#define WFF2 ((bf16*)(wl + W_FF2))
#define SS1 (SS + (size_t)(3 * l) * TT)
#define SS2 (SS + (size_t)(3 * l + 1) * TT)
#define SS3 (SS + (size_t)(3 * l + 2) * TT)
#define SS1n (SS + (size_t)(3 * ((l + 1) & 1)) * TT)

        if (sp == 0 && EN_PRO) {
            PHASE_IDS
            LAS float* scr = (LAS float*)(lds + wid * 16384);
            int rot = 0;
#define CONVW(src, Nsrc, K, ndst, blk, sblk, soff, gain, dst) do { int gwr = gw - rot % NGW; if (gwr < 0) gwr += NGW; conv_w(src, Nsrc, K, ndst, blk, sblk, soff, gain, dst, scr, gwr, NGW, lane); rot += ((K) / 64) * ((ndst) / 32); } while (0)
#pragma unroll 1
            for (int ll = 0; ll < 2; ++ll) {
                unsigned char* w2 = ws + OFF_W + (size_t)ll * W_LAYER;
                CONVW(P.in[35] + (size_t)ll * 1024 * 4096, 4096, 1024, 4096, 4096, 4096, 0, P.in[34] + ll * 1024, (bf16*)(w2 + W_FF1));
                CONVW(P.in[36] + (size_t)ll * 4096 * 1024, 1024, 4096, 1024, 1024, 1024, 0, nullptr, (bf16*)(w2 + W_FF2));
                CONVW(P.in[9] + (size_t)ll * 1024 * 1440, 1440, 1024, 1440, 1440, 1440, 0, P.in[8] + ll * 1024, (bf16*)(w2 + W_WIN));
                CONVW(P.in[18] + (size_t)ll * 256 * 768, 768, 256, 768, 768, 768, 0, P.in[17] + ll * 256, (bf16*)(w2 + W_WUQ));
                CONVW(P.in[20] + (size_t)ll * 128 * 1024, 1024, 128, 512, -1, 128, 0, nullptr, (bf16*)(w2 + W_WK));
                CONVW(P.in[20] + (size_t)ll * 128 * 1024, 1024, 128, 512, 64, 128, 64, nullptr, (bf16*)(w2 + W_WVT));
                CONVW(P.in[25] + (size_t)ll * 1024 * 1024, 1024, 1024, 1024, 1024, 1024, 0, nullptr, (bf16*)(w2 + W_WOUT));
                CONVW(P.in[28] + (size_t)ll * 1024 * 512, 512, 1024, 512, 512, 512, 0, P.in[26] + ll * 1024, (bf16*)(w2 + W_WMQ));
                CONVW(P.in[29] + (size_t)ll * 1024 * 512, 512, 1024, 512, 512, 512, 0, P.in[27] + ll * 1024, WMKV + (size_t)(ll * 1024) * 1024);
                CONVW(P.in[30] + (size_t)ll * 1024 * 512, 512, 1024, 512, 512, 512, 0, P.in[27] + ll * 1024, WMKV + (size_t)(ll * 1024 + 512) * 1024);
                CONVW(P.in[31] + (size_t)ll * 512 * 1024, 1024, 512, 1024, 1024, 1024, 0, nullptr, (bf16*)(w2 + W_WMO));
#pragma unroll 1
                for (int i = gtid; i < 96 * 1024 / 8; i += GT) ((u32x4*)((bf16*)(w2 + W_WIN) + (size_t)1440 * 1024))[i] = (u32x4){0u, 0u, 0u, 0u};
            }
#pragma unroll 1
            for (int lb = 0; lb < 16; ++lb) { const int ll = lb >> 3, b2 = lb & 7;
                CONVW(P.in[7] + (size_t)(ll * 8 + b2) * 256 * 512, 512, 256, 512, 512, 512, 0, nullptr, MVT + (size_t)((ll * 12 + 4 + b2) * 4) * 128 * 256); }
#undef CONVW
#pragma unroll 1
            for (int row = gw; row < TV; row += 2 * NGW) {
                const int row2 = row + NGW; const bool has2 = row2 < TV;
                const float* xr = row < TP ? P.in[0] + (size_t)row * 1024 : P.in[1] + (size_t)(row - TP) * 1024;
                const float* xr2 = !has2 ? xr : row2 < TP ? P.in[0] + (size_t)row2 * 1024 : P.in[1] + (size_t)(row2 - TP) * 1024;
                f32x4 va[4], vb[4];
#pragma unroll
                for (int j = 0; j < 4; ++j) { va[j] = ((const f32x4*)xr)[lane + 64 * j]; vb[j] = ((const f32x4*)xr2)[lane + 64 * j]; }
                float sa = 0.f, sb = 0.f;
#pragma unroll
                for (int j = 0; j < 4; ++j) { sa += (va[j][0] * va[j][0] + va[j][1] * va[j][1]) + (va[j][2] * va[j][2] + va[j][3] * va[j][3]);
                    sb += (vb[j][0] * vb[j][0] + vb[j][1] * vb[j][1]) + (vb[j][2] * vb[j][2] + vb[j][3] * vb[j][3]);
                    u32x2 w; w.x = pk2(va[j][0], va[j][1]); w.y = pk2(va[j][2], va[j][3]); ((u32x2*)(XB + (size_t)row * 1024))[lane + 64 * j] = w;
                    if (has2) { w.x = pk2(vb[j][0], vb[j][1]); w.y = pk2(vb[j][2], vb[j][3]); ((u32x2*)(XB + (size_t)row2 * 1024))[lane + 64 * j] = w; } }
                sa = wave_sum(sa); sb = wave_sum(sb);
                if (lane == 0) { SS[row] = sa; if (has2) SS[row2] = sb; }
            }
            { int i = TV + gtid; while (i < 6 * TT) { SS[i] = 0.f; i += GT; asm volatile("" : "+v"(i)); } }
#pragma unroll 1
            for (int row = gw; row < 1024; row += NGW) { const float s = row_to_bf16(P.in[2] + (size_t)row * 1024, MEMB + (size_t)row * 1024, lane); if (lane == 0) MSS[row] = s; }
#pragma unroll 1
            for (int it = gw; it < 16 * 128; it += NGW) {
                const int k = it & 15, pos = (it >> 4) * 64 + lane, k3 = k & 3, k2 = k >> 2;
                const double b0 = k3 == 0 ? 1.0 : k3 == 1 ? 0.5623413251903491 : k3 == 2 ? 0.31622776601683794 : 0.1778279410038923;
                const double d0 = k2 == 0 ? 1.0 : k2 == 1 ? 0.1 : k2 == 2 ? 0.01 : 0.001;
                const double ang = (double)pos * (b0 * d0);
                const double kk = __builtin_rint(ang * 0.15915494309189535);
                const float r = (float)(ang - kk * 6.283185307179586);
                ROPE[2 * (pos * 16 + k)] = cosf(r); ROPE[2 * (pos * 16 + k) + 1] = sinf(r);
            }
#pragma unroll 1
            for (int row = gw; row < 2 * 8 * 256; row += NGW) {
                const int ll = row >> 11, b = (row >> 8) & 7, mm = row & 255, h = lane >> 4, d0 = 8 * (lane & 15);
                const float* ks = P.in[6] + (size_t)row * 512 + 8 * lane;
                const f32x4 k0 = *(const f32x4*)ks, k1 = *(const f32x4*)(ks + 4);
                u32x4 w; w.x = pk2(k0[0], k0[1]); w.y = pk2(k0[2], k0[3]); w.z = pk2(k1[0], k1[1]); w.w = pk2(k1[2], k1[3]);
                *(u32x4*)(MK + ((size_t)((ll * 12 + 4 + b) * 4 + h) * 256 + mm) * 128 + d0) = w;
            }
            __syncthreads();
        }

        {
            const int ng = !EN_GEMM ? 0 : (sp == 1) ? (l == 0 ? 2 : 1) : (sp == 3) ? 3 : (sp == 6 || sp == 7 || sp == 9 || sp == 10 || sp == 11) ? 1 : 0;
#pragma unroll 1
            for (int gi = 0; gi < ng; ++gi) {
                pg8::Gemm g; bool sk = true; EpiU E; E.mode = 0; E.relu2 = 0; E.out = nullptr; E.ldc = 0; E.ss = nullptr; E.ssdiv = 1.0f / 1024.0f; E.ssout = nullptr; E.base_p = nullptr; E.base_s = nullptr; E.xb = nullptr; E.gkn = nullptr; E.kr = nullptr; E.kh = nullptr; E.khs = nullptr;
                if (sp == 1 && gi == 0) { g = pg8::Gemm{XB, WIN, TP, 1536, 1024}; E.out = Hb; E.ldc = 1536; E.ss = SS1; }
                else if (sp == 1) { g = pg8::Gemm{MEMB, WMKV, 1024, 2048, 1024}; sk = false; E.mode = 2; E.out = MKVRAW; E.ldc = 2048; E.ss = MSS; }
                else if (sp == 3 && gi == 0) { g = pg8::Gemm{CQ, WUQ, TP, 768, 256}; E.out = QRAW; E.ldc = 768; }
                else if (sp == 3 && gi == 1) { g = pg8::Gemm{LATC, WK, LR, 512, 128}; sk = false; E.mode = 3; E.gkn = P.in[23] + l * 64; E.kr = KR; E.kh = KH; E.khs = KHS; }
                else if (sp == 3) { g = pg8::Gemm{WVT, LATC, 512, LR, 128}; sk = false; E.out = VT; E.ldc = LR; }
                else if (sp == 6) { g = pg8::Gemm{MIX, WOUT, TP, 1024, 1024}; E.mode = 1; E.out = nullptr; E.ldc = 1024; E.ssout = SS2; E.xb = XB; }
                else if (sp == 7) { g = pg8::Gemm{XB, WMQ, TP, 512, 1024}; E.out = QMRAW; E.ldc = 512; E.ss = SS2; }
                else if (sp == 9) { g = pg8::Gemm{OM, WMO, TP, 1024, 512}; E.mode = 1; E.out = nullptr; E.ldc = 1024; E.ssout = SS3; E.xb = XB; }
                else if (sp == 10) { g = pg8::Gemm{XB, WFF1, TP, 4096, 1024}; E.out = HID; E.ldc = 4096; E.ss = SS3; E.relu2 = 1; }
                else { g = pg8::Gemm{HID, WFF2, TP, 1024, 4096}; E.mode = 1; E.out = l == 1 ? dout : nullptr; E.ldc = 1024; E.ssout = SS1n; E.xb = XB; }
                const int rotc = (sp == 3 && (G & 7) == 0) ? (bid + G - (gi == 1 ? G / 2 : gi == 2 ? (3 * G) / 4 : 0)) % G : bid;
                pg8::StaticOrder S; S.init(g.M, g.N, G, rotc);
                if (E.mode != 2) { EpiP Ep; Ep.mode = E.mode; Ep.relu2 = E.relu2; Ep.out = E.out; Ep.ldc = E.ldc; Ep.ss = E.ss; Ep.ssdiv = E.ssdiv; Ep.ssout = E.ssout; Ep.xb = E.xb;
                    Ep.gkn = E.gkn; Ep.kr = E.kr; Ep.kh = E.kh; Ep.khs = E.khs;
                    pg8::gemm_phase<EpiP, pg8::StaticOrder, true, true>(lds, g, S, Ep); }
                else pg8::gemm_phase<EpiU, pg8::StaticOrder, true, true>(lds, g, S, E);
                __syncthreads();
                if (sk) { PHASE_IDS skinny_gemm(g.A + (size_t)TP * g.K, g.Bt, g.N, g.K, E, gw, NGW, lane); }
            }
        }

        if (sp == 2 && EN_E1) {
            PHASE_IDS
            const float* g_a = P.in[10] + l * 256; const float* g_kva = P.in[19] + l * 128; const float* g_kr = P.in[24] + l * 32;
            const f32x4 gA = *(const f32x4*)(g_a + 4 * lane), gKVA = *(const f32x4*)(g_kva + 4 * (lane & 31)), gKR = *(const f32x4*)(g_kr + 4 * (lane & 7));
            u32x2 cu = {0u, 0u}, cv = {0u, 0u}, ca = {0u, 0u}, cg_ = {0u, 0u}, cq = {0u, 0u}, cl = {0u, 0u}, ck = {0u, 0u};
            u32x2 nu = {0u, 0u}, nv = {0u, 0u}, na = {0u, 0u}, ng_ = {0u, 0u}, nq = {0u, 0u}, nl = {0u, 0u}, nk = {0u, 0u};
            if (gw < TV) { const bf16* h_ = Hb + (size_t)gw * 1536 + 4 * lane; cu = *(const u32x2*)(h_); cv = *(const u32x2*)(h_ + 256); ca = *(const u32x2*)(h_ + 512);
                cg_ = *(const u32x2*)(h_ + 768); cq = *(const u32x2*)(h_ + 1024); if (lane < 32) cl = *(const u32x2*)(h_ + 1280); if (lane < 8) ck = *(const u32x2*)(h_ + 1408); }
#pragma unroll 1
            for (int row = gw; row < TV; row += NGW) {
                if (row + NGW < TV) { const bf16* h_ = Hb + (size_t)(row + NGW) * 1536 + 4 * lane; nu = *(const u32x2*)(h_); nv = *(const u32x2*)(h_ + 256); na = *(const u32x2*)(h_ + 512);
                    ng_ = *(const u32x2*)(h_ + 768); nq = *(const u32x2*)(h_ + 1024); if (lane < 32) nl = *(const u32x2*)(h_ + 1280); if (lane < 8) nk = *(const u32x2*)(h_ + 1408); }
                const bool samp = row >= TP;
                int b, t; if (!samp) { b = row >> 13; t = row & 8191; } else { b = (row - TP) >> 4; t = (row - TP) & 15; }
                const int pos = samp ? 1024 + t : t; const int c4 = 4 * lane;
                const float* rp = ROPE + (size_t)pos * 32 + 8 * (lane & 3); const f32x4 cs0 = *(const f32x4*)rp, cs1 = *(const f32x4*)(rp + 4);
                {
                    const u32x2 r = cu; u32x2 w; w.x = pk2(gelu_f(bflo(r.x)), gelu_f(bfhi(r.x))); w.y = pk2(gelu_f(bflo(r.y)), gelu_f(bfhi(r.y)));
                    *(u32x2*)(UG + (size_t)row * 256 + c4) = w; }
                {
                    const u32x2 r = cv; float v0 = gelu_f(bflo(r.x)), v1 = gelu_f(bfhi(r.x)), v2 = gelu_f(bflo(r.y)), v3 = gelu_f(bfhi(r.y));
                    const float rs = rsqrtf(wave_sum((v0 * v0 + v1 * v1) + (v2 * v2 + v3 * v3)) * (1.0f / 256.0f) + EPS); const f32x4 g = gA;
                    v0 *= rs * g[0]; v1 *= rs * g[1]; v2 *= rs * g[2]; v3 *= rs * g[3];
                    u32x2 w; w.x = pk2(v0, v1); w.y = pk2(v2, v3); *(u32x2*)(VG + (size_t)row * 256 + c4) = w;
                    if (samp) *(f32x4*)(dout + O_GVS + ((size_t)(l * 8 + b) * 16 + t) * 256 + c4) = (f32x4){v0, v1, v2, v3}; }
                {
                    const u32x2 a = ca, gt = cg_;
                    const float z0 = bflo(a.x) * sigm_f(bflo(gt.x)), z1 = bfhi(a.x) * sigm_f(bfhi(gt.x)), z2 = bflo(a.y) * sigm_f(bflo(gt.y)), z3 = bfhi(a.y) * sigm_f(bfhi(gt.y));
                    u32x2 w; w.x = pk2(z0, z1); w.y = pk2(z2, z3); *(u32x2*)(Zb + (size_t)row * 256 + c4) = w;
                    if (!samp) { if (t >= 8162) *(f32x4*)(dout + O_CONVP + ((size_t)(l * 4 + b) * 30 + (t - 8162)) * 256 + c4) = (f32x4){z0, z1, z2, z3}; }
                    else { *(f32x4*)(dout + O_CONVS + ((size_t)(l * 8 + b) * 30 + 14 + t) * 256 + c4) = (f32x4){z0, z1, z2, z3};
                           if (t < 14) *(f32x4*)(dout + O_CONVS + ((size_t)(l * 8 + b) * 30 + t) * 256 + c4) = *(const f32x4*)(P.in[5] + ((size_t)(l * 8 + b) * 30 + 16 + t) * 256 + c4); } }
                {
                    const u32x2 r = cq; float v0 = bflo(r.x), v1 = bfhi(r.x), v2 = bflo(r.y), v3 = bfhi(r.y);
                    const float rs = rsqrtf(wave_sum((v0 * v0 + v1 * v1) + (v2 * v2 + v3 * v3)) * (1.0f / 256.0f) + EPS);
                    u32x2 w; w.x = pk2(v0 * rs, v1 * rs); w.y = pk2(v2 * rs, v3 * rs); *(u32x2*)(CQ + (size_t)row * 256 + c4) = w; }
                const size_t lrow = samp ? (size_t)TP + b * SKV + 1024 + t : (size_t)row;
                {
                    float v0 = 0.f, v1 = 0.f, v2 = 0.f, v3 = 0.f;
                    if (lane < 32) { const u32x2 r = cl; v0 = bflo(r.x); v1 = bfhi(r.x); v2 = bflo(r.y); v3 = bfhi(r.y); }
                    const float rs = rsqrtf(wave_sum((v0 * v0 + v1 * v1) + (v2 * v2 + v3 * v3)) * (1.0f / 128.0f) + EPS);
                    if (lane < 32) { const f32x4 g = gKVA; v0 *= rs * g[0]; v1 *= rs * g[1]; v2 *= rs * g[2]; v3 *= rs * g[3];
                        float* op = samp ? dout + O_LATS + ((size_t)(l * 8 + b) * 16 + t) * 128 : dout + O_LATP + ((size_t)(l * 4 + b) * 8192 + t) * 128;
                        *(f32x4*)(op + c4) = (f32x4){v0, v1, v2, v3}; u32x2 w; w.x = pk2(v0, v1); w.y = pk2(v2, v3); *(u32x2*)(LATC + lrow * 128 + c4) = w; } }
                {
                    float v0 = 0.f, v1 = 0.f, v2 = 0.f, v3 = 0.f;
                    if (lane < 8) { const u32x2 r = ck; v0 = bflo(r.x); v1 = bfhi(r.x); v2 = bflo(r.y); v3 = bfhi(r.y); }
                    const float rs = rsqrtf(wave_sum((v0 * v0 + v1 * v1) + (v2 * v2 + v3 * v3)) * (1.0f / 32.0f) + EPS);
                    if (lane < 8) { const f32x4 g = gKR; v0 *= rs * g[0]; v1 *= rs * g[1]; v2 *= rs * g[2]; v3 *= rs * g[3]; }
#define XOR4(v) __builtin_bit_cast(float, __builtin_amdgcn_ds_bpermute((lane ^ 4) << 2, __builtin_bit_cast(int, (v))))
                    const float o0 = XOR4(v0), o1 = XOR4(v1), o2 = XOR4(v2), o3 = XOR4(v3);
#undef XOR4
                    if (lane < 8) {
                        float r0, r1, r2, r3;
                        if (lane < 4) { r0 = v0 * cs0[0] - o0 * cs0[1]; r1 = v1 * cs0[2] - o1 * cs0[3]; r2 = v2 * cs1[0] - o2 * cs1[1]; r3 = v3 * cs1[2] - o3 * cs1[3]; }
                        else          { r0 = o0 * cs0[1] + v0 * cs0[0]; r1 = o1 * cs0[3] + v1 * cs0[2]; r2 = o2 * cs1[1] + v2 * cs1[0]; r3 = o3 * cs1[3] + v3 * cs1[2]; }
                        float* op = samp ? dout + O_KRS + ((size_t)(l * 8 + b) * 16 + t) * 32 : dout + O_KRP + ((size_t)(l * 4 + b) * 8192 + t) * 32;
                        *(f32x4*)(op + c4) = (f32x4){r0, r1, r2, r3}; u32x2 w; w.x = pk2(r0, r1); w.y = pk2(r2, r3); *(u32x2*)(KR + lrow * 32 + c4) = w; } }
                cu = nu; cv = nv; ca = na; cg_ = ng_; cq = nq; cl = nl; ck = nk;
            }
#pragma unroll 1
            for (int i = gtid; i < 8 * 1024 * 16; i += GT) { const int b = i >> 14, t = (i >> 4) & 1023, c = i & 15;
                const float* s = P.in[3] + ((size_t)(l * 8 + b) * 1024 + t) * 128 + 8 * c; const f32x4 a = *(const f32x4*)s, bb = *(const f32x4*)(s + 4);
                u32x4 w; w.x = pk2(a[0], a[1]); w.y = pk2(a[2], a[3]); w.z = pk2(bb[0], bb[1]); w.w = pk2(bb[2], bb[3]);
                *(u32x4*)(LATC + ((size_t)TP + b * SKV + t) * 128 + 8 * c) = w; }
#pragma unroll 1
            for (int i = gtid; i < 8 * 1024 * 4; i += GT) { const int b = i >> 12, t = (i >> 2) & 1023, c = i & 3;
                const float* s = P.in[4] + ((size_t)(l * 8 + b) * 1024 + t) * 32 + 8 * c; const f32x4 a = *(const f32x4*)s, bb = *(const f32x4*)(s + 4);
                u32x4 w; w.x = pk2(a[0], a[1]); w.y = pk2(a[2], a[3]); w.z = pk2(bb[0], bb[1]); w.w = pk2(bb[2], bb[3]);
                *(u32x4*)(KR + ((size_t)TP + b * SKV + t) * 32 + 8 * c) = w; }
            if (l == 0) {
#pragma unroll 1
                for (int it = gw; it < 2048; it += NGW) { const int ll = it >> 10, row = it & 1023, b = row >> 8, mm = row & 255, h = lane >> 4, d0 = 8 * (lane & 15);
                    const float* kp = MKVRAW + (size_t)row * 2048 + ll * 1024 + 8 * lane; const float* vp = kp + 512;
                    f32x4 k0 = *(const f32x4*)kp, k1 = *(const f32x4*)(kp + 4); const f32x4 v0 = *(const f32x4*)vp, v1 = *(const f32x4*)(vp + 4);
                    float s = (k0[0] * k0[0] + k0[1] * k0[1]) + (k0[2] * k0[2] + k0[3] * k0[3]) + (k1[0] * k1[0] + k1[1] * k1[1]) + (k1[2] * k1[2] + k1[3] * k1[3]);
                    s = sum16(s);
                    const float rs = rsqrtf(s * (1.0f / 128.0f) + EPS); const float* gk = P.in[33] + ll * 128 + d0;
                    const f32x4 g0 = *(const f32x4*)gk, g1 = *(const f32x4*)(gk + 4); k0 = k0 * rs * g0; k1 = k1 * rs * g1;
                    float* ok = dout + O_MKP + ((size_t)(ll * 4 + b) * 256 + mm) * 512 + 8 * lane; float* ov = dout + O_MVP + ((size_t)(ll * 4 + b) * 256 + mm) * 512 + 8 * lane;
                    *(f32x4*)ok = k0; *(f32x4*)(ok + 4) = k1; *(f32x4*)ov = v0; *(f32x4*)(ov + 4) = v1;
                    u32x4 w; w.x = pk2(k0[0], k0[1]); w.y = pk2(k0[2], k0[3]); w.z = pk2(k1[0], k1[1]); w.w = pk2(k1[2], k1[3]);
                    *(u32x4*)(MK + ((size_t)((ll * 12 + b) * 4 + h) * 256 + mm) * 128 + d0) = w;
                }
                LAS float* scr = (LAS float*)(lds + wid * 16384);
#pragma unroll 1
                for (int lb = 0; lb < 8; ++lb) { const int ll = lb >> 2, b2 = lb & 3; int gwr = gw - (lb * 64) % NGW; if (gwr < 0) gwr += NGW;
                    conv_w(MKVRAW + (size_t)(b2 * 256) * 2048 + ll * 1024 + 512, 2048, 256, 512, 512, 512, 0, nullptr, MVT + (size_t)((ll * 12 + b2) * 4) * 128 * 256, scr, gwr, NGW, lane); }
            }
        }

        if (sp == 3 && EN_E2) {
            PHASE_IDS
            constexpr int GV_OFF = 128 * 272;
#pragma unroll 1
            for (int g = 0; g < 4; ++g) {
                const float* wsg = P.in[11] + ((size_t)(l * 4 + g) * 128) * 128; const float* bsg = P.in[12] + (l * 4 + g) * 128;
#pragma unroll 1
                for (int c = tid; c < 128 * 16; c += 512) { const int i = c >> 4, j0 = (c & 15) * 8; const f32x4 a = *(const f32x4*)(wsg + i * 128 + j0), b2 = *(const f32x4*)(wsg + i * 128 + j0 + 4);
                    float e[8] = {a[0], a[1], a[2], a[3], b2[0], b2[1], b2[2], b2[3]};
#pragma unroll
                    for (int k = 0; k < 8; ++k) if (j0 + k > i) e[k] = 0.f;
                    u32x4 w; w.x = pk2(e[0], e[1]); w.y = pk2(e[2], e[3]); w.z = pk2(e[4], e[5]); w.w = pk2(e[6], e[7]);
                    *(LAS u32x4*)(lds + i * 272 + j0 * 2) = w; }
#pragma unroll 1
                for (int u = bid; u < 256 + 256; u += G) {
                    if (u >= 256 && !(G == 256 ? (u - 256 >= 224 && ((u - 256 - 224) >> 3) == g) : (u - 256 < 8))) continue;
                    const int row0 = u < 256 ? 128 * u : TP + 16 * ((u - 256) & 7), nrows = u < 256 ? 128 : 16;
#pragma unroll 1
                    for (int c = tid; c < 128 * 16; c += 512) { const int j = c >> 4, d0 = (c & 15) * 4; u32x2 v = {0u, 0u};
                        if (j < nrows) v = *(const u32x2*)(VG + (size_t)(row0 + j) * 256 + g * 64 + d0);
                        *(LAS bf16*)(lds + GV_OFF + (d0 + 0) * 272 + j * 2) = (bf16)(v.x & 0xffffu); *(LAS bf16*)(lds + GV_OFF + (d0 + 1) * 272 + j * 2) = (bf16)(v.x >> 16);
                        *(LAS bf16*)(lds + GV_OFF + (d0 + 2) * 272 + j * 2) = (bf16)(v.y & 0xffffu); *(LAS bf16*)(lds + GV_OFF + (d0 + 3) * 272 + j * 2) = (bf16)(v.y >> 16); }
                    __syncthreads();
                    if (wid * 16 < nrows) {
                        pg8::f32x4 acc[4];
#pragma unroll
                        for (int dt = 0; dt < 4; ++dt) acc[dt] = (pg8::f32x4){0.f, 0.f, 0.f, 0.f};
                        const int i = 16 * wid + (lane & 15), kb = lane >> 4, nks = (16 * wid + 15) / 32 + 1;
                        for (int ks = 0; ks < nks; ++ks) {
                            const bf16x8 a = *(const LAS bf16x8*)(lds + i * 272 + (32 * ks + 8 * kb) * 2);
#pragma unroll
                            for (int dt = 0; dt < 4; ++dt) { const bf16x8 bfr = *(const LAS bf16x8*)(lds + GV_OFF + (16 * dt + (lane & 15)) * 272 + (32 * ks + 8 * kb) * 2);
                                acc[dt] = __builtin_amdgcn_mfma_f32_16x16x32_bf16(bfr, a, acc[dt], 0, 0, 0); }
                        }
                        const int ii = 16 * wid + (lane & 15); const float bsi = bsg[ii];
#pragma unroll
                        for (int dt = 0; dt < 4; ++dt) { const int d = 16 * dt + 4 * (lane >> 4);
                            const u32x2 uu = *(const u32x2*)(UG + (size_t)(row0 + ii) * 256 + g * 64 + d);
                            u32x2 w; w.x = pk2((acc[dt][0] + bsi) * bflo(uu.x), (acc[dt][1] + bsi) * bfhi(uu.x)); w.y = pk2((acc[dt][2] + bsi) * bflo(uu.y), (acc[dt][3] + bsi) * bfhi(uu.y));
                            *(u32x2*)(MIX + (size_t)(row0 + ii) * 1024 + g * 64 + d) = w; }
                    }
                    __syncthreads();
                }
            }
            const float* dww = P.in[13] + (size_t)l * 31 * 256; const float* dwb = P.in[14] + l * 256; const float* lng = P.in[15] + l * 256; const float* lnb = P.in[16] + l * 256;
            const f32x4 bias = *(const f32x4*)(dwb + 4 * lane), gg = *(const f32x4*)(lng + 4 * lane), bb = *(const f32x4*)(lnb + 4 * lane);
#pragma unroll 1
            for (int u0 = bid; u0 < 1024 + 256; u0 += G) {
                int u = u0;
                if (u0 >= 1024) { const int j = u0 - 1024; if (G == 256 ? (j < 216 || j >= 224) : (j >= 8)) continue; u = 1024 + (j & 7); }
                const bool samp = u >= 1024; const int b = samp ? u - 1024 : u >> 8; const int zrow0 = samp ? TP + 16 * b : b * 8192 + 32 * (u & 255);
                const int ntok = samp ? 16 : 32; const bool zero_hist = !samp && (u & 255) == 0; const float* hist = samp ? P.in[5] + (size_t)(l * 8 + b) * 30 * 256 : nullptr;
                const int nrows = 30 + ntok;
#pragma unroll 1
                for (int c = tid; c < nrows * 32; c += 512) { const int rr = c >> 5, cc = (c & 31) * 8; u32x4 v = {0u, 0u, 0u, 0u};
                    if (rr < 30) { if (hist) { const f32x4 a = *(const f32x4*)(hist + rr * 256 + cc), b2 = *(const f32x4*)(hist + rr * 256 + cc + 4); v.x = pk2(a[0], a[1]); v.y = pk2(a[2], a[3]); v.z = pk2(b2[0], b2[1]); v.w = pk2(b2[2], b2[3]); }
                                   else if (!zero_hist) v = *(const u32x4*)(Zb + (size_t)(zrow0 - 30 + rr) * 256 + cc); }
                    else v = *(const u32x4*)(Zb + (size_t)(zrow0 + rr - 30) * 256 + cc);
                    *(LAS u32x4*)(lds + rr * 512 + cc * 2) = v; }
                __syncthreads();
                {
                    const int tpw = ntok >> 3;
                    const int c4 = 4 * lane; f32x4 acc[4];
#pragma unroll
                    for (int j = 0; j < 4; ++j) acc[j] = bias;
#pragma unroll 1
                    for (int k = 0; k < 31; ++k) { const f32x4 w = *(const f32x4*)(dww + k * 256 + c4);
#pragma unroll
                        for (int j = 0; j < 4; ++j) if (j < tpw) { const u32x2 z = *(const LAS u32x2*)(lds + (tpw * wid + j + k) * 512 + c4 * 2);
                            acc[j][0] += w[0] * bflo(z.x); acc[j][1] += w[1] * bfhi(z.x); acc[j][2] += w[2] * bflo(z.y); acc[j][3] += w[3] * bfhi(z.y); } }
#pragma unroll
                    for (int j = 0; j < 4; ++j) if (j < tpw) { const float mean = wave_sum((acc[j][0] + acc[j][1]) + (acc[j][2] + acc[j][3])) * (1.0f / 256.0f);
                        const f32x4 xc = acc[j] - mean; const float var = wave_sum((xc[0] * xc[0] + xc[1] * xc[1]) + (xc[2] * xc[2] + xc[3] * xc[3])) * (1.0f / 256.0f);
                        const float rs = rsqrtf(var + EPS); f32x4 y = xc * rs * gg + bb;
                        y[0] *= sigm_f(y[0]); y[1] *= sigm_f(y[1]); y[2] *= sigm_f(y[2]); y[3] *= sigm_f(y[3]);
                        u32x2 w2; w2.x = pk2(y[0], y[1]); w2.y = pk2(y[2], y[3]); *(u32x2*)(MIX + (size_t)(zrow0 + tpw * wid + j) * 1024 + 256 + c4) = w2; }
                }
                __syncthreads();
            }
        }

        if (false) {
            PHASE_IDS
            const float* gkn = P.in[23] + l * 64;
#pragma unroll 1
            for (int r = gw; r < LRV; r += NGW) {
                const u32x4 raw = *(const u32x4*)(KRAW + (size_t)r * 512 + 8 * lane);
                float x[8] = {bflo(raw.x), bfhi(raw.x), bflo(raw.y), bfhi(raw.y), bflo(raw.z), bfhi(raw.z), bflo(raw.w), bfhi(raw.w)};
                float s = 0.f;
#pragma unroll
                for (int j = 0; j < 8; ++j) s += x[j] * x[j];
                s = sum8(s);
                const float rs = rsqrtf(s * (1.0f / 64.0f) + EPS); const int hh = lane >> 3, d0 = 8 * (lane & 7);
                const f32x4 g0 = *(const f32x4*)(gkn + d0), g1 = *(const f32x4*)(gkn + d0 + 4);
                u32x4 w; w.x = pk2(x[0] * rs * g0[0], x[1] * rs * g0[1]); w.y = pk2(x[2] * rs * g0[2], x[3] * rs * g0[3]); w.z = pk2(x[4] * rs * g1[0], x[5] * rs * g1[1]); w.w = pk2(x[6] * rs * g1[2], x[7] * rs * g1[3]);
                bf16* dst;
                if (r < TP) { const int b = r >> 13, t = r & 8191; dst = KH + ((size_t)(b * 8 + hh) * 8192 + t) * 96; }
                else { const int rr = r - TP, b = rr / SKV, t = rr - b * SKV; dst = KHS + ((size_t)(b * 8 + hh) * KHS_T + t) * 96; }
                *(u32x4*)(dst + d0) = w;
                *(u32x2*)(dst + 64 + 4 * (lane & 7)) = *(const u32x2*)(KR + (size_t)r * 32 + 4 * (lane & 7));
            }
        }

        if (sp == 5 && EN_ATT) {
            PHASE_IDS
            const float* gqn = P.in[21] + l * 64; const float* gqr = P.in[22] + l * 32;
            const int r32 = lane & 31, hi = lane >> 5;
            const int vcu = (bid & 7) * 32 + (bid >> 3);
#pragma unroll 1
            for (int ui = 0;; ++ui) {
                int bh, qb;
                if (G == 256) { if (ui >= 4) break; const int xcd = bid & 7, v = bid >> 3, s = v & 15;
                    bh = 4 * xcd + 2 * (ui >> 1) + (v >> 4); qb = (ui & 1) ? 31 - s : s; }
                else { const int u = bid + ui * G; if (u >= 1024) break; bh = u >> 5; qb = u & 31; }
                const int b = bh >> 3, h = bh & 7; const int t = qb * 256 + wid * 32 + r32; const size_t row = (size_t)b * 8192 + t;
                bf16x8 q[6]; load_q_mla(q, QRAW + row * 768 + h * 96, hi, gqn, gqr, ROPE + (size_t)t * 32);
                f32x16 o[2]; float lsum;
                attn_block<96, 64>(ldc_, q, KH + (size_t)bh * 8192 * 96, VT + (size_t)(h * 64) * LR + (size_t)b * 8192, LR, 4 * qb + 4, 4 * qb + (wid >> 1) + 1, 1 << 30, o, lsum);
                attn_store<2>(o, lsum, MIX + row * 1024 + 512 + h * 64, hi, true);
            }
#pragma unroll 1
            for (int u = bid; u < 64; u += G) {
                const int b = u >> 3, h = u & 7, tq = min(r32, 15); const size_t row = (size_t)TP + b * 16 + tq;
                bf16x8 q[6]; load_q_mla(q, QRAW + row * 768 + h * 96, hi, gqn, gqr, ROPE + (size_t)(1024 + tq) * 32);
                f32x16 o[2]; float lsum;
                attn_block<96, 64>(ldc_, q, KHS + (size_t)(b * 8 + h) * KHS_T * 96, VT + (size_t)(h * 64) * LR + TP + b * SKV, LR, 17, wid == 0 ? 17 : 0, SKV, o, lsum);
                attn_store<2>(o, lsum, MIX + row * 1024 + 512 + h * 64, hi, wid == 0 && r32 < 16);
            }
        }

        if (sp == 8 && EN_MATT) {
            PHASE_IDS
            const float* gq = P.in[32] + l * 128; const int r32 = lane & 31, hi = lane >> 5;
#pragma unroll 1
            for (int u = bid; u < 512; u += G) {
                const int b = u >> 7, h = (u >> 5) & 3, qt = u & 31; const size_t row = (size_t)b * 8192 + qt * 256 + wid * 32 + r32;
                bf16x8 q[8]; load_q_mem(q, QMRAW + row * 512 + h * 128, hi, gq);
                f32x16 o[4]; float lsum;
                attn_block<128, 128>(ldc_, q, MK + (size_t)((l * 12 + b) * 4 + h) * 256 * 128, MVT + (size_t)((l * 12 + b) * 4 + h) * 128 * 256, 256, 4, 4, 1 << 30, o, lsum);
                attn_store<4>(o, lsum, OM + row * 512 + h * 128, hi, true);
            }
#pragma unroll 1
            for (int u = bid; u < 32; u += G) {
                const int b = u >> 2, h = u & 3, tq = min(r32, 15); const size_t row = (size_t)TP + b * 16 + tq;
                bf16x8 q[8]; load_q_mem(q, QMRAW + row * 512 + h * 128, hi, gq);
                f32x16 o[4]; float lsum;
                attn_block<128, 128>(ldc_, q, MK + (size_t)((l * 12 + 4 + b) * 4 + h) * 256 * 128, MVT + (size_t)((l * 12 + 4 + b) * 4 + h) * 128 * 256, 256, 4, wid == 0 ? 4 : 0, 256, o, lsum);
                attn_store<4>(o, lsum, OM + row * 512 + h * 128, hi, wid == 0 && r32 < 16);
            }
        }

        if (ph + 1 < P.ph_hi) { if (P.ph_hi > NPHASE) grid.sync(); else xcd_barrier(bar); }
#if REPEAT_SP
        if ((REPEAT_SP == 100 ? sp == 0 : sp == REPEAT_SP) && !redone) { redone = 1; --ph; } else redone = 0;
#endif
#if DOUBLE_SYNC
        if (ph + 1 < P.ph_hi) xcd_barrier(bar);
#endif
    }
}

#ifndef MULTI_LAUNCH
#define MULTI_LAUNCH 0
#endif
extern "C" void kernel_launch(void* const* d_in, const int* in_sizes, int n_in, void* d_out, int out_size, void* d_ws, size_t ws_size, hipStream_t stream) {
    static int grid = 0;
    if (grid == 0) {
        if (n_in != 37 || out_size != (int)O_END || ws_size < WS_END) { fprintf(stderr, "kernel_launch: unexpected shapes n_in %d out %d ws %zu (need %zu)\n", n_in, out_size, ws_size, (size_t)WS_END); grid = -1; return; }
        int dev = 0, cus = 0, per_cu = 0;
        hipGetDevice(&dev); hipDeviceGetAttribute(&cus, hipDeviceAttributeMultiprocessorCount, dev);
        hipFuncSetAttribute((const void*)fwd_kernel, hipFuncAttributeMaxDynamicSharedMemorySize, LDS_BYTES);
        hipOccupancyMaxActiveBlocksPerMultiprocessor(&per_cu, (const void*)fwd_kernel, 512, LDS_BYTES);
        if (per_cu < 1) per_cu = 1;
        (void)hipGetLastError();
        grid = cus * per_cu;
        if (grid > 256) grid = 256;
    }
    if (grid < 0) return;
    if (hipMemsetAsync((char*)d_ws + OFF_CTL, 0, CTL_BYTES, stream) != hipSuccess) { fprintf(stderr, "kernel_launch: memset failed\n"); return; }
    Params p{};
    for (int i = 0; i < 37; ++i) p.in[i] = (const float*)d_in[i];
    p.out = (float*)d_out; p.ws = (unsigned char*)d_ws;
#if MULTI_LAUNCH
    for (int ph = 0; ph < NPHASE; ++ph) { p.ph_lo = ph; p.ph_hi = ph + 1; hipLaunchKernelGGL(fwd_kernel, dim3(grid), dim3(512), LDS_BYTES, stream, p); }
#else
    p.ph_lo = 0; p.ph_hi = NPHASE;
    void* args[] = {&p};
    hipError_t e = hipLaunchCooperativeKernel((const void*)fwd_kernel, dim3(grid), dim3(512), args, LDS_BYTES, stream);
    if (e != hipSuccess) fprintf(stderr, "cooperative launch failed: %s (grid %d)\n", hipGetErrorString(e), grid);
#endif
}
```

```cpp
#include <hip/hip_runtime.h>
#include <hip/hip_cooperative_groups.h>
#include <cstdio>
#include <cstdint>
namespace cg = cooperative_groups;
namespace pg8 {
#define PG8_LAS __attribute__((address_space(3)))
typedef unsigned short bf16_t;
typedef short bf16x8 __attribute__((ext_vector_type(8)));
typedef float f32x4 __attribute__((ext_vector_type(4)));
typedef unsigned u32x4 __attribute__((ext_vector_type(4)));
constexpr int BM = 256, BK = 64, HALF = 128, HTB = HALF * BK * 2  , STAGE_BYTES = 8 * HTB, NXCD = 8, WGM = 8;

__host__ __device__ __forceinline__ int lds_byte(int r, int c) { const int st = (r >> 4) * 2 + (c >> 5), rr = r & 15, cc = c & 31, ob = rr * 64 + cc * 2; return st * 1024 + (ob ^ (((ob >> 9) & 1) << 5)); }
__host__ __device__ __forceinline__ void stage_rc(int b, int& R, int& C) { const int st = b / 1024, sb = b % 1024, swz = sb ^ (((sb >> 9) & 1) << 5); R = (st >> 1) * 16 + swz / 64; C = (st & 1) * 32 + (swz % 64) / 2; }
__host__ __device__ __forceinline__ int perm32(int rho) { const int n = rho >> 4, i = rho & 15; return 8 * (i >> 2) + 4 * n + (i & 3); }

struct Unit { int pm, pn; };
struct Gemm { const bf16_t* A; const bf16_t* Bt; int M, N, K; };

struct StaticOrder {
    int nM, nN, nwg, G, c;
    __host__ __device__ void init(int M, int N, int G_, int c_) { nM = M / BM; nN = N / BM; nwg = nM * nN; G = G_; c = c_; }
    __host__ __device__ bool next(int i, Unit& u) const {
        const long L = (long)i * G + c; if (L >= nwg) return false;
        int wgid = (int)L; { const int q = nwg / NXCD, r = nwg % NXCD, xcd = wgid % NXCD, off = wgid / NXCD; wgid = (xcd < r ? xcd * (q + 1) : r * (q + 1) + (xcd - r) * q) + off; }
        const int nig = WGM * nN, gid = wgid / nig, fm = gid * WGM, gsz = (nM - fm) < WGM ? (nM - fm) : WGM;
        u.pm = fm + ((wgid % nig) % gsz); u.pn = (wgid % nig) / gsz; return true;
    }
    __device__ __forceinline__ void a_ready(const Unit&) const {}
    __device__ __forceinline__ void done(const Unit&) const {}
};

__device__ __forceinline__ unsigned cvt_pk_bf16(float lo, float hi) { unsigned r; asm volatile("v_cvt_pk_bf16_f32 %0, %1, %2" : "=v"(r) : "v"(lo), "v"(hi)); return r; }
typedef float f32x2 __attribute__((ext_vector_type(2)));
__device__ __forceinline__ f32x2 gelu_pk(f32x2 v) {
    const f32x2 av = __builtin_elementwise_abs(v), d = av * 0.2316418882f + 1.0f;
    f32x2 t; t.x = __builtin_amdgcn_rcpf(d.x); t.y = __builtin_amdgcn_rcpf(d.y);
    f32x2 q = t * 0.5307027145f + (-0.7265760135f); q = q * t + 0.7107068705f; q = q * t + (-0.142248368f); q = q * t + 0.127414796f; q = q * t;
    const f32x2 s = (v * v) * (-0.72134752044f);
    f32x2 e; e.x = __builtin_amdgcn_exp2f(s.x); e.y = __builtin_amdgcn_exp2f(s.y);
    const f32x2 m = v * (q * e), r = v - m;
    f32x2 o; o.x = v.x < 0.f ? m.x : r.x; o.y = v.y < 0.f ? m.y : r.y; return o;
}

template <class Epi, class Sched, bool ALIGN_EPI = false, bool SP2 = false>
__device__ __forceinline__ void gemm_phase(PG8_LAS unsigned char* lds, const Gemm g, const Sched& S, const Epi& E) {
    int tid = threadIdx.x; asm volatile("" : "+v"(tid));
    const int wid = __builtin_amdgcn_readfirstlane(tid >> 6), lane = tid & 63, wr = wid >> 2, wc = wid & 3, fr = lane & 15, fq = lane >> 4;
    const int K = g.K, nt = K / BK;
    unsigned voffA[2], voffB[2];
#pragma unroll
    for (int i = 0; i < 2; ++i) { int R, C; stage_rc(tid * 16 + i * 8192, R, C); const int Rb = Epi::PERM ? ((R & ~31) + perm32(R & 31)) : R;
        voffA[i] = (unsigned)(R * K + C) * 2u; voffB[i] = (unsigned)(Rb * K + C) * 2u; }
    const size_t kstep = (size_t)(BK * 2);
    const size_t hstep = (size_t)HALF * K * 2;
    const size_t tstep = 2 * hstep;
    const unsigned ldsw = (unsigned)wid * 1024u;
    const int aoff = lds_byte(wr * 64 + fr, fq * 8), boff = lds_byte(wc * 32 + fr, fq * 8);
#define PG8_SA(b, h) (((b) * 2 + (h)) * HTB)
#define PG8_SB(b, h) ((4 + (b) * 2 + (h)) * HTB)
#define PG8_STAGE(bufoff, gbase, voff) do { _Pragma("unroll") for (int _i = 0; _i < 2; ++_i) \
        __builtin_amdgcn_global_load_lds((const unsigned*)((const char*)(gbase) + (voff)[_i]), (PG8_LAS unsigned*)(lds + (bufoff) + ldsw + _i * 8192), 16, 0, 0); } while (0)
#define PG8_LDA(dst, b, h) do { _Pragma("unroll") for (int m = 0; m < 4; ++m) _Pragma("unroll") for (int k = 0; k < 2; ++k) dst[m][k] = *(const PG8_LAS bf16x8*)(lds + PG8_SA(b, h) + aoff + m * 2048 + k * 1024); } while (0)
#define PG8_LDB(dst, b, h) do { _Pragma("unroll") for (int n = 0; n < 2; ++n) _Pragma("unroll") for (int k = 0; k < 2; ++k) dst[n][k] = *(const PG8_LAS bf16x8*)(lds + PG8_SB(b, h) + boff + n * 2048 + k * 1024); } while (0)
#define PG8_MMA(ai, bj, At, Bt) do { __builtin_amdgcn_s_setprio(1); _Pragma("unroll") for (int m = 0; m < 4; ++m) _Pragma("unroll") for (int n = 0; n < 2; ++n) _Pragma("unroll") for (int k = 0; k < 2; ++k) \
        acc[ai][bj][m][n] = __builtin_amdgcn_mfma_f32_16x16x32_bf16(Bt[n][k], At[m][k], acc[ai][bj][m][n], 0, 0, 0); __builtin_amdgcn_s_setprio(0); } while (0)
#define PG8_WAIT_V(n) asm volatile("s_waitcnt vmcnt(" #n ")" ::: "memory")
#define PG8_WAIT_L(n) asm volatile("s_waitcnt lgkmcnt(" #n ")" ::: "memory")
#define PG8_BAR __builtin_amdgcn_s_barrier()
#define PG8_SCHED __builtin_amdgcn_sched_barrier(0)
    Unit cur, nxt; int ui = 0;
    if (!S.next(0, cur)) return;
    f32x4 acc[2][2][4][2];
#pragma unroll
    for (int a = 0; a < 2; ++a)
#pragma unroll
        for (int b = 0; b < 2; ++b)
#pragma unroll
            for (int m = 0; m < 4; ++m)
#pragma unroll
                for (int n = 0; n < 2; ++n) acc[a][b][m][n] = (f32x4){0.f, 0.f, 0.f, 0.f};
    bf16x8 At[4][2], B0[2][2], B1[2][2];
    const char* cA = (const char*)g.A + (size_t)cur.pm * tstep; const char* cB = (const char*)g.Bt + (size_t)cur.pn * tstep;
    S.a_ready(cur);
    if constexpr (SP2) {
        PG8_STAGE(PG8_SB(0, 0), cB, voffB); PG8_STAGE(PG8_SB(0, 1), cB + hstep, voffB); PG8_STAGE(PG8_SA(0, 0), cA, voffA); PG8_STAGE(PG8_SA(0, 1), cA + hstep, voffA);
        if (wr == 1) PG8_BAR;
        PG8_WAIT_V(2); PG8_BAR;
        PG8_STAGE(PG8_SB(1, 0), cB + kstep, voffB); PG8_STAGE(PG8_SA(1, 0), cA + kstep, voffA); PG8_STAGE(PG8_SB(1, 1), cB + hstep + kstep, voffB);
        PG8_WAIT_V(6); PG8_BAR;
    } else {
        PG8_STAGE(PG8_SB(0, 0), cB, voffB); PG8_STAGE(PG8_SA(0, 0), cA, voffA); PG8_STAGE(PG8_SB(0, 1), cB + hstep, voffB); PG8_STAGE(PG8_SA(0, 1), cA + hstep, voffA);
        if (wr == 1) PG8_BAR;
        PG8_WAIT_V(4); PG8_BAR;
        PG8_STAGE(PG8_SB(1, 0), cB + kstep, voffB); PG8_STAGE(PG8_SA(1, 0), cA + kstep, voffA); PG8_STAGE(PG8_SB(1, 1), cB + hstep + kstep, voffB);
        PG8_WAIT_V(6); PG8_BAR;
    }
    for (;;) {
        const bool has_next = S.next(ui + 1, nxt);
        const char* nA = has_next ? (const char*)g.A + (size_t)nxt.pm * tstep : cA; const char* nB = has_next ? (const char*)g.Bt + (size_t)nxt.pn * tstep : cB;
        for (int t = 0; t < nt; t += 2) {
            const bool last = (t == nt - 2);
            const char* a1 = cA + (size_t)(t + 1) * kstep;
            const char* a2 = last ? nA : cA + (size_t)(t + 2) * kstep; const char* b2 = last ? nB : cB + (size_t)(t + 2) * kstep;
            const char* a3 = a2 + kstep; const char* b3 = b2 + kstep;
            if (last && has_next) S.a_ready(nxt);
            if constexpr (SP2) {
            PG8_LDB(B0, 0, 0); PG8_LDB(B1, 0, 1); PG8_SCHED; PG8_LDA(At, 0, 0); PG8_STAGE(PG8_SA(1, 1), a1 + hstep, voffA);
            PG8_WAIT_V(8); PG8_WAIT_L(0); PG8_BAR; PG8_MMA(0, 0, At, B0); PG8_MMA(0, 1, At, B1); PG8_BAR; PG8_SCHED;
            PG8_LDA(At, 0, 1); PG8_STAGE(PG8_SB(0, 0), b2, voffB); PG8_STAGE(PG8_SB(0, 1), b2 + hstep, voffB); PG8_STAGE(PG8_SA(0, 0), a2, voffA);
            PG8_WAIT_V(8); PG8_WAIT_L(0); PG8_BAR; PG8_MMA(1, 0, At, B0); PG8_MMA(1, 1, At, B1); PG8_BAR; PG8_SCHED;
            PG8_LDB(B0, 1, 0); PG8_LDB(B1, 1, 1); PG8_SCHED; PG8_LDA(At, 1, 0); PG8_STAGE(PG8_SA(0, 1), a2 + hstep, voffA);
            PG8_WAIT_V(8); PG8_WAIT_L(0); PG8_BAR; PG8_MMA(0, 0, At, B0); PG8_MMA(0, 1, At, B1); PG8_BAR; PG8_SCHED;
            PG8_LDA(At, 1, 1); PG8_STAGE(PG8_SB(1, 0), b3, voffB); PG8_STAGE(PG8_SB(1, 1), b3 + hstep, voffB); PG8_STAGE(PG8_SA(1, 0), a3, voffA);
            PG8_WAIT_V(8); PG8_WAIT_L(0); PG8_BAR; PG8_MMA(1, 0, At, B0); PG8_MMA(1, 1, At, B1); PG8_BAR; PG8_SCHED;
            } else {
            PG8_LDB(B0, 0, 0); PG8_SCHED; PG8_LDA(At, 0, 0); PG8_STAGE(PG8_SA(1, 1), a1 + hstep, voffA);
            PG8_WAIT_L(8); PG8_BAR; PG8_WAIT_L(0); PG8_MMA(0, 0, At, B0); PG8_BAR; PG8_SCHED;
            PG8_LDB(B1, 0, 1); PG8_STAGE(PG8_SB(0, 0), b2, voffB);
            PG8_BAR; PG8_WAIT_L(0); PG8_MMA(0, 1, At, B1); PG8_BAR;
            PG8_LDA(At, 0, 1); PG8_STAGE(PG8_SA(0, 0), a2, voffA);
            PG8_BAR; PG8_WAIT_L(0); PG8_MMA(1, 0, At, B0); PG8_BAR; PG8_SCHED;
            PG8_STAGE(PG8_SB(0, 1), b2 + hstep, voffB);
            PG8_WAIT_V(6); PG8_BAR; PG8_MMA(1, 1, At, B1); PG8_BAR;
            PG8_LDB(B0, 1, 0); PG8_SCHED; PG8_LDA(At, 1, 0); PG8_STAGE(PG8_SA(0, 1), a2 + hstep, voffA);
            PG8_WAIT_L(8); PG8_BAR; PG8_WAIT_L(0); PG8_MMA(0, 0, At, B0); PG8_BAR; PG8_SCHED;
            PG8_LDB(B1, 1, 1); PG8_STAGE(PG8_SB(1, 0), b3, voffB);
            PG8_BAR; PG8_WAIT_L(0); PG8_MMA(0, 1, At, B1); PG8_BAR;
            PG8_LDA(At, 1, 1); PG8_STAGE(PG8_SA(1, 0), a3, voffA);
            PG8_BAR; PG8_WAIT_L(0); PG8_MMA(1, 0, At, B0); PG8_BAR; PG8_SCHED;
            PG8_STAGE(PG8_SB(1, 1), b3 + hstep, voffB);
            PG8_WAIT_V(6); PG8_BAR; PG8_MMA(1, 1, At, B1); PG8_BAR;
            }
        }
        if constexpr (ALIGN_EPI) { if (wr == 0) PG8_BAR; }
        if constexpr (!Epi::AFTER_DRAIN) { E(acc, cur, wr, wc, fr, fq); S.done(cur); }
        if (!has_next) break;
#pragma unroll
        for (int a = 0; a < 2; ++a)
#pragma unroll
            for (int b = 0; b < 2; ++b)
#pragma unroll
                for (int m = 0; m < 4; ++m)
#pragma unroll
                    for (int n = 0; n < 2; ++n) acc[a][b][m][n] = (f32x4){0.f, 0.f, 0.f, 0.f};
        cur = nxt; cA = nA; cB = nB; ++ui;
        if constexpr (ALIGN_EPI) { if (wr == 1) PG8_BAR; }
    }
    PG8_WAIT_V(0);
    if constexpr (!ALIGN_EPI) { if (wr == 0) PG8_BAR; }
    PG8_BAR;
    if constexpr (Epi::AFTER_DRAIN) { E.fused(acc, cur, wr, wc, fr, fq, lds, wid, lane); S.done(cur); }
#undef PG8_SA
#undef PG8_SB
#undef PG8_STAGE
#undef PG8_LDA
#undef PG8_LDB
#undef PG8_MMA
#undef PG8_WAIT_V
#undef PG8_WAIT_L
#undef PG8_BAR
#undef PG8_SCHED
}
}

#define LAS __attribute__((address_space(3)))
typedef unsigned short bf16;
typedef unsigned u32x4 __attribute__((ext_vector_type(4)));
typedef unsigned u32x2 __attribute__((ext_vector_type(2)));
typedef float f32x4 __attribute__((ext_vector_type(4)));
typedef float f32x16 __attribute__((ext_vector_type(16)));
typedef short bf16x8 __attribute__((ext_vector_type(8)));

constexpr int TP = 32768, TV = 32896, TT = 33024;
constexpr int LR = 41216, LRV = 41088;
constexpr int SKV = 1040, KHS_T = 1104;
constexpr float EPS = 1e-6f;
constexpr float LOG2E = 1.4426950408889634f;
constexpr float SC_MLA = 0.10206207261596577f * LOG2E;
constexpr float SC_MEM = 0.08838834764831845f * LOG2E;

constexpr size_t al256(size_t x) { return (x + 255) & ~(size_t)255; }
constexpr size_t OFF_CTL = 0, CTL_BYTES = 16384;
constexpr size_t OFF_SS = CTL_BYTES;
constexpr size_t OFF_MSS = al256(OFF_SS + (size_t)6 * TT * 4);
constexpr size_t OFF_ROPE = al256(OFF_MSS + 1024 * 4);
constexpr size_t W_WIN = 0, W_WUQ = W_WIN + (size_t)1536 * 1024 * 2, W_WK = W_WUQ + (size_t)768 * 256 * 2, W_WVT = W_WK + (size_t)512 * 128 * 2,
                 W_WOUT = W_WVT + (size_t)512 * 128 * 2, W_WMQ = W_WOUT + (size_t)1024 * 1024 * 2, W_WMO = W_WMQ + (size_t)512 * 1024 * 2,
                 W_FF1 = W_WMO + (size_t)1024 * 512 * 2, W_FF2 = W_FF1 + (size_t)4096 * 1024 * 2, W_LAYER = W_FF2 + (size_t)1024 * 4096 * 2;
constexpr size_t OFF_W = al256(OFF_ROPE + (size_t)8192 * 16 * 8);
constexpr size_t OFF_WMKV = OFF_W + 2 * W_LAYER;
constexpr size_t OFF_MEMB = OFF_WMKV + (size_t)2048 * 1024 * 2;
constexpr size_t OFF_MKVRAW = OFF_MEMB + (size_t)1024 * 1024 * 2;
constexpr size_t OFF_MK = OFF_MKVRAW + (size_t)1024 * 2048 * 4;
constexpr size_t OFF_MVT = OFF_MK + (size_t)2 * 12 * 4 * 256 * 128 * 2;
constexpr size_t OFF_XB = OFF_MVT + (size_t)2 * 12 * 4 * 256 * 128 * 2;
constexpr size_t OFF_LATC = OFF_XB + (size_t)TT * 1024 * 2;
constexpr size_t OFF_KR = OFF_LATC + (size_t)LR * 128 * 2;
constexpr size_t OFF_UG = OFF_KR + (size_t)LR * 32 * 2;
constexpr size_t OFF_VG = OFF_UG + (size_t)TT * 256 * 2, OFF_Z = OFF_VG + (size_t)TT * 256 * 2, OFF_CQ = OFF_Z + (size_t)TT * 256 * 2;
constexpr size_t OFF_A = OFF_CQ + (size_t)TT * 256 * 2;
constexpr size_t SZ_A = (size_t)TT * 1536 * 2;
constexpr size_t OFF_H = OFF_A, OFF_QRAW = OFF_A, OFF_KRAW = OFF_A + (size_t)TT * 768 * 2, OFF_QMRAW = OFF_A, OFF_OM = OFF_A + (size_t)TT * 512 * 2;
static_assert((size_t)TT * 768 * 2 + (size_t)LR * 512 * 2 <= SZ_A, "region A");
constexpr size_t OFF_B = OFF_A + SZ_A;
constexpr size_t OFF_VT = OFF_B, OFF_KH = OFF_VT + (size_t)512 * LR * 2, OFF_KHS = OFF_KH + (size_t)32 * 8192 * 96 * 2;
constexpr size_t OFF_C = OFF_KHS + (size_t)64 * KHS_T * 96 * 2;
constexpr size_t OFF_MIX = OFF_C;
constexpr size_t OFF_HID = OFF_A;
constexpr size_t WS_END = OFF_MIX + (size_t)TT * 1024 * 2;
static_assert(OFF_HID + (size_t)TT * 4096 * 2 <= WS_END, "HID overlay");

constexpr size_t O_YP = 0, O_YS = 33554432, O_LATP = 33685504, O_KRP = 42074112, O_CONVP = 44171264, O_MKP = 44232704, O_MVP = 45281280,
                 O_LATS = 46329856, O_KRS = 46362624, O_CONVS = 46370816, O_GVS = 46493696, O_END = 46559232;

constexpr int LDS_BYTES = 147456;
constexpr int NPHASE = 23;

struct Params { const float* in[37]; float* out; unsigned char* ws; int ph_lo, ph_hi; };

__device__ __forceinline__ float bflo(unsigned w) { return __uint_as_float(w << 16); }
__device__ __forceinline__ float bfhi(unsigned w) { return __uint_as_float(w & 0xffff0000u); }
__device__ __forceinline__ unsigned pk2(float lo, float hi) {
    typedef float f2_t __attribute__((ext_vector_type(2))); typedef __bf16 b2_t __attribute__((ext_vector_type(2)));
    f2_t v = {lo, hi}; b2_t b = __builtin_convertvector(v, b2_t); return __builtin_bit_cast(unsigned, b);
}
template <int CTRL> __device__ __forceinline__ float dpp_add(float v) {
    return v + __builtin_bit_cast(float, __builtin_amdgcn_update_dpp(0, __builtin_bit_cast(int, v), CTRL, 0xf, 0xf, true));
}
__device__ __forceinline__ float sum4(float v) { v = dpp_add<0xB1>(v); return dpp_add<0x4E>(v); }
__device__ __forceinline__ float sum8(float v) { return dpp_add<0x141>(sum4(v)); }
__device__ __forceinline__ float sum16(float v) { return dpp_add<0x140>(sum8(v)); }
__device__ __forceinline__ float swap16_sum(float v) {
    auto rr = __builtin_amdgcn_permlane16_swap(__float_as_uint(v), __float_as_uint(v), false, false);
    return __uint_as_float(rr[0]) + __uint_as_float(rr[1]);
}
__device__ __forceinline__ float half_sum(float v);
__device__ __forceinline__ float wave_sum(float v) { return half_sum(swap16_sum(sum16(v))); }
__device__ __forceinline__ float half_sum(float v) {
    auto rr = __builtin_amdgcn_permlane32_swap(__float_as_uint(v), __float_as_uint(v), false, false);
    return __uint_as_float(rr[0]) + __uint_as_float(rr[1]);
}
__device__ __forceinline__ float half_max(float v) {
    auto rr = __builtin_amdgcn_permlane32_swap(__float_as_uint(v), __float_as_uint(v), false, false);
    return fmaxf(__uint_as_float(rr[0]), __uint_as_float(rr[1]));
}
__device__ __forceinline__ float gelu_f(float x) { return 0.5f * x * (1.0f + erff(x * 0.70710678118654752f)); }
__device__ __forceinline__ float sigm_f(float x) { return 1.0f / (1.0f + __expf(-x)); }

struct EpiU {
    static constexpr bool PERM = false, AFTER_DRAIN = false;
    int mode;
    int relu2;
    void* out; int ldc;
    const float* ss; float ssdiv;
    float* ssout;
    const float* base_p; const float* base_s; bf16* xb;
    const float* gkn; const bf16* kr; bf16* kh; bf16* khs;
    __device__ __forceinline__ void operator()(const pg8::f32x4 (&acc)[2][2][4][2], const pg8::Unit& u, int wr, int wc, int fr, int fq) const {
        const int row0 = u.pm * 256 + wr * 64 + fr, col0 = u.pn * 256 + wc * 32 + 4 * fq;
#pragma unroll
        for (int ai = 0; ai < 2; ++ai)
#pragma unroll
            for (int m = 0; m < 4; ++m) {
                const int row = row0 + ai * 128 + m * 16;
                const float rs = ss ? rsqrtf(ss[row] * ssdiv + EPS) : 1.0f;
#pragma unroll
                for (int bj = 0; bj < 2; ++bj)
#pragma unroll
                    for (int n = 0; n < 2; ++n) { const int c = col0 + bj * 128 + n * 16; *(f32x4*)((float*)out + (size_t)row * ldc + c) = acc[ai][bj][m][n] * rs; }
            }
    }
};

struct EpiP {
    static constexpr bool PERM = true, AFTER_DRAIN = false;
    int mode;
    int relu2; void* out; int ldc; const float* ss; float ssdiv; float* ssout; bf16* xb;
    const float* gkn; const bf16* kr; bf16* kh; bf16* khs;
    __device__ __forceinline__ void operator()(const pg8::f32x4 (&acc)[2][2][4][2], const pg8::Unit& u, int wr, int wc, int fr, int fq) const {
        const int row0 = u.pm * 256 + wr * 64 + fr, col0 = u.pn * 256 + wc * 32 + 8 * fq;
        if (mode == 0) {
            float rsv[2][4];
#pragma unroll
            for (int ai = 0; ai < 2; ++ai)
#pragma unroll
                for (int m = 0; m < 4; ++m) rsv[ai][m] = ss ? ss[row0 + ai * 128 + m * 16] : 0.f;
#pragma unroll
            for (int ai = 0; ai < 2; ++ai)
#pragma unroll
                for (int m = 0; m < 4; ++m) {
                    const int row = row0 + ai * 128 + m * 16;
                    const float rs = ss ? rsqrtf(rsv[ai][m] * ssdiv + EPS) : 1.0f;
                    bf16* rowp = (bf16*)out + (size_t)row * ldc + col0;
#pragma unroll
                    for (int bj = 0; bj < 2; ++bj) { f32x4 v0 = acc[ai][bj][m][0] * rs, v1 = acc[ai][bj][m][1] * rs;
                        if (relu2) { v0[0] = fmaxf(v0[0], 0.f); v0[1] = fmaxf(v0[1], 0.f); v0[2] = fmaxf(v0[2], 0.f); v0[3] = fmaxf(v0[3], 0.f); v0 = v0 * v0;
                                     v1[0] = fmaxf(v1[0], 0.f); v1[1] = fmaxf(v1[1], 0.f); v1[2] = fmaxf(v1[2], 0.f); v1[3] = fmaxf(v1[3], 0.f); v1 = v1 * v1; }
                        u32x4 w; w.x = pk2(v0[0], v0[1]); w.y = pk2(v0[2], v0[3]); w.z = pk2(v1[0], v1[1]); w.w = pk2(v1[2], v1[3]);
                        *(u32x4*)(rowp + bj * 128) = w; }
                }
        } else if (mode == 1) {
#pragma unroll
            for (int ai = 0; ai < 2; ++ai) {
                u32x4 bwv[4][2];
#pragma unroll
                for (int m = 0; m < 4; ++m)
#pragma unroll
                    for (int bj = 0; bj < 2; ++bj) bwv[m][bj] = *(const u32x4*)(xb + (size_t)(row0 + ai * 128 + m * 16) * 1024 + col0 + bj * 128);
#pragma unroll
                for (int m = 0; m < 4; ++m) {
                    const int row = row0 + ai * 128 + m * 16; float s2 = 0.f;
                    bf16* xp = xb + (size_t)row * 1024 + col0; float* op = (float*)out + (size_t)row * 1024 + col0;
#pragma unroll
                    for (int bj = 0; bj < 2; ++bj) { const u32x4 bw = bwv[m][bj];
                        const f32x4 x0 = (f32x4){bflo(bw.x), bfhi(bw.x), bflo(bw.y), bfhi(bw.y)} + acc[ai][bj][m][0], x1 = (f32x4){bflo(bw.z), bfhi(bw.z), bflo(bw.w), bfhi(bw.w)} + acc[ai][bj][m][1];
                        if (out) { *(f32x4*)(op + bj * 128) = x0; *(f32x4*)(op + bj * 128 + 4) = x1; }
                        else { u32x4 w; w.x = pk2(x0[0], x0[1]); w.y = pk2(x0[2], x0[3]); w.z = pk2(x1[0], x1[1]); w.w = pk2(x1[2], x1[3]); *(u32x4*)(xp + bj * 128) = w; }
                        s2 += ((x0[0] * x0[0] + x0[1] * x0[1]) + (x0[2] * x0[2] + x0[3] * x0[3])) + ((x1[0] * x1[0] + x1[1] * x1[1]) + (x1[2] * x1[2] + x1[3] * x1[3])); }
                    s2 = half_sum(swap16_sum(s2));
                    if (fq == 0) unsafeAtomicAdd(ssout + row, s2);
                }
            }
        } else {
            const int hh = 4 * u.pn + wc;
            f32x4 gv[2][2];
#pragma unroll
            for (int bj = 0; bj < 2; ++bj)
#pragma unroll
                for (int n = 0; n < 2; ++n) gv[bj][n] = *(const f32x4*)(gkn + 32 * bj + 8 * fq + 4 * n);
            u32x4 krv[2][4];
#pragma unroll
            for (int ai = 0; ai < 2; ++ai)
#pragma unroll
                for (int m = 0; m < 4; ++m) { const int r = row0 + ai * 128 + m * 16; krv[ai][m] = *(const u32x4*)(kr + (size_t)(r < LRV ? r : 0) * 32 + 8 * fq); }
#pragma unroll
            for (int ai = 0; ai < 2; ++ai)
#pragma unroll
                for (int m = 0; m < 4; ++m) {
                    const int r = row0 + ai * 128 + m * 16; float s2 = 0.f;
#pragma unroll
                    for (int bj = 0; bj < 2; ++bj)
#pragma unroll
                        for (int n = 0; n < 2; ++n) { const f32x4 x = acc[ai][bj][m][n]; s2 += (x[0] * x[0] + x[1] * x[1]) + (x[2] * x[2] + x[3] * x[3]); }
                    s2 = half_sum(swap16_sum(s2));
                    const float rs = rsqrtf(s2 * (1.0f / 64.0f) + EPS);
                    if (r < LRV) {
                        bf16* dst;
                        if (r < TP) { const int b = r >> 13, t = r & 8191; dst = kh + ((size_t)(b * 8 + hh) * 8192 + t) * 96; }
                        else { const int rr = r - TP, b = rr / SKV, t = rr - b * SKV; dst = khs + ((size_t)(b * 8 + hh) * KHS_T + t) * 96; }
#pragma unroll
                        for (int bj = 0; bj < 2; ++bj) { const f32x4 v0 = acc[ai][bj][m][0] * rs * gv[bj][0], v1 = acc[ai][bj][m][1] * rs * gv[bj][1];
                            u32x4 w; w.x = pk2(v0[0], v0[1]); w.y = pk2(v0[2], v0[3]); w.z = pk2(v1[0], v1[1]); w.w = pk2(v1[2], v1[3]);
                            *(u32x4*)(dst + 32 * bj + 8 * fq) = w; }
                        *(u32x4*)(dst + 64 + 8 * fq) = krv[ai][m];
                    }
                }
        }
    }
};

#define MFMA32(a, b, c) __builtin_amdgcn_mfma_f32_32x32x16_bf16((a), (b), (c), 0, 0, 0)
template <int KSTR, int VSTR> struct SrcLds {
    const LAS char* k; const LAS char* v;
    __device__ __forceinline__ bf16x8 kfrag(int hf, int s) const { return *(const LAS bf16x8*)(k + hf * 32 * KSTR + s * 32); }
    __device__ __forceinline__ bf16x8 vfrag(int dd, int hf, int s2) const { return *(const LAS bf16x8*)(v + dd * 32 * VSTR + hf * 64 + s2 * 32); }
};
#define MX3(a, b, c) __builtin_fmaxf(__builtin_fmaxf((a), (b)), (c))
template <int NS, int ND, class Src>
__device__ __forceinline__ void attn_tile(const bf16x8 (&q)[NS], f32x16 (&o)[ND], bool& shifted, float& m, float& l, const Src& src, int kvalid, int hi) {
    f32x16 z;
#pragma unroll
    for (int r = 0; r < 16; ++r) z[r] = 0.f;
    constexpr bool BATCH = (NS == 6);
    f32x16 p0, p1; bf16x8 vfa[ND][2];
    if constexpr (BATCH) {
        bf16x8 k0[NS], k1[NS];
#pragma unroll
        for (int s = 0; s < NS; ++s) { k0[s] = src.kfrag(0, s); k1[s] = src.kfrag(1, s); }
        __builtin_amdgcn_sched_barrier(0);
        p0 = MFMA32(k0[0], q[0], z); p1 = MFMA32(k1[0], q[0], z);
#pragma unroll
        for (int s = 1; s < NS; ++s) { p0 = MFMA32(k0[s], q[s], p0); p1 = MFMA32(k1[s], q[s], p1); }
#pragma unroll
        for (int dd = 0; dd < ND; ++dd) { vfa[dd][0] = src.vfrag(dd, 0, 0); vfa[dd][1] = src.vfrag(dd, 0, 1); }
        __builtin_amdgcn_sched_barrier(0);
    } else {
        { bf16x8 kk[NS];
#pragma unroll
          for (int s = 0; s < NS; ++s) kk[s] = src.kfrag(0, s);
          __builtin_amdgcn_sched_barrier(0);
          p0 = MFMA32(kk[0], q[0], z);
#pragma unroll
          for (int s = 1; s < NS; ++s) p0 = MFMA32(kk[s], q[s], p0); }
        __builtin_amdgcn_sched_barrier(0);
        { bf16x8 kk[NS];
#pragma unroll
          for (int s = 0; s < NS; ++s) kk[s] = src.kfrag(1, s);
          __builtin_amdgcn_sched_barrier(0);
          p1 = MFMA32(kk[0], q[0], z);
#pragma unroll
          for (int s = 1; s < NS; ++s) p1 = MFMA32(kk[s], q[s], p1); }
        __builtin_amdgcn_sched_barrier(0);
    }
    if (kvalid < 64) {
#pragma unroll
        for (int r = 0; r < 16; ++r) { const int kv = 16 * (r >> 3) + 8 * hi + (r & 7); if (kv >= kvalid) p0[r] = -INFINITY; if (kv + 32 >= kvalid) p1[r] = -INFINITY; }
    }
    float ma = MX3(p0[0], p0[1], p1[0]), mb = MX3(p0[2], p0[3], p1[1]); ma = MX3(ma, p1[2], p1[3]);
#pragma unroll
    for (int r = 4; r < 16; r += 4) { ma = MX3(ma, p0[r], p0[r + 1]); mb = MX3(mb, p0[r + 2], p0[r + 3]); ma = MX3(ma, p1[r], p1[r + 1]); mb = MX3(mb, p1[r + 2], p1[r + 3]); }
    const float mx = half_max(fmaxf(ma, mb)) - m;
    if (__any(fabsf(mx) > 8.0f)) {
        const float dl = fabsf(mx) > 8.0f ? mx : 0.0f; m += dl;
        const float f = __builtin_amdgcn_exp2f(-dl); l *= f;
#pragma unroll
        for (int dd = 0; dd < ND; ++dd) o[dd] = o[dd] * f;
        shifted = __any(m != 0.0f);
    }
    if (shifted) {
#pragma unroll
        for (int r = 0; r < 16; ++r) { p0[r] -= m; p1[r] -= m; }
    }
    float sum = 0.f; bf16x8 pb0, pb1;
#pragma unroll
    for (int r = 0; r < 16; ++r) { p0[r] = __builtin_amdgcn_exp2f(p0[r]); sum += p0[r]; }
    { u32x4 w; w.x = pk2(p0[0], p0[1]); w.y = pk2(p0[2], p0[3]); w.z = pk2(p0[4], p0[5]); w.w = pk2(p0[6], p0[7]); pb0 = __builtin_bit_cast(bf16x8, w);
      w.x = pk2(p0[8], p0[9]); w.y = pk2(p0[10], p0[11]); w.z = pk2(p0[12], p0[13]); w.w = pk2(p0[14], p0[15]); pb1 = __builtin_bit_cast(bf16x8, w); }
    bf16x8 vfb[ND][2];
    if constexpr (BATCH) {
#pragma unroll
        for (int dd = 0; dd < ND; ++dd) { vfb[dd][0] = src.vfrag(dd, 1, 0); vfb[dd][1] = src.vfrag(dd, 1, 1); }
        __builtin_amdgcn_sched_barrier(0);
#pragma unroll
        for (int dd = 0; dd < ND; ++dd) { o[dd] = MFMA32(vfa[dd][0], pb0, o[dd]); o[dd] = MFMA32(vfa[dd][1], pb1, o[dd]); }
    } else {
#pragma unroll
        for (int dd = 0; dd < ND; ++dd) { vfa[dd][0] = src.vfrag(dd, 0, 0); vfa[dd][1] = src.vfrag(dd, 0, 1); }
        __builtin_amdgcn_sched_barrier(0);
#pragma unroll
        for (int dd = 0; dd < ND; ++dd) { o[dd] = MFMA32(vfa[dd][0], pb0, o[dd]); o[dd] = MFMA32(vfa[dd][1], pb1, o[dd]); }
        __builtin_amdgcn_sched_barrier(0);
    }
#pragma unroll
    for (int r = 0; r < 16; ++r) { p1[r] = __builtin_amdgcn_exp2f(p1[r]); sum += p1[r]; }
    { u32x4 w; w.x = pk2(p1[0], p1[1]); w.y = pk2(p1[2], p1[3]); w.z = pk2(p1[4], p1[5]); w.w = pk2(p1[6], p1[7]); pb0 = __builtin_bit_cast(bf16x8, w);
      w.x = pk2(p1[8], p1[9]); w.y = pk2(p1[10], p1[11]); w.z = pk2(p1[12], p1[13]); w.w = pk2(p1[14], p1[15]); pb1 = __builtin_bit_cast(bf16x8, w); }
    if constexpr (!BATCH) {
#pragma unroll
        for (int dd = 0; dd < ND; ++dd) { vfa[dd][0] = src.vfrag(dd, 1, 0); vfa[dd][1] = src.vfrag(dd, 1, 1); }
        __builtin_amdgcn_sched_barrier(0);
    }
#pragma unroll
    for (int dd = 0; dd < ND; ++dd) { if constexpr (BATCH) { o[dd] = MFMA32(vfb[dd][0], pb0, o[dd]); o[dd] = MFMA32(vfb[dd][1], pb1, o[dd]); }
                                      else { o[dd] = MFMA32(vfa[dd][0], pb0, o[dd]); o[dd] = MFMA32(vfa[dd][1], pb1, o[dd]); } }
    l += sum;
}

template <int DQK, int DV>
__device__ __forceinline__ void attn_block(LAS char* lds, const bf16x8 (&q)[DQK / 16], const bf16* Kg, const bf16* Vg, int vstride, int ntile, int mynt, int kvlen,
                                           f32x16 (&o)[DV / 32], float& lsum) {
    constexpr int NS = DQK / 16, ND = DV / 32, KSTR = DQK * 2 + 16, VSTR = 144, KB = 64 * KSTR, VB = DV * VSTR, BUF = KB + VB;
    constexpr int KCH = DQK / 8, NKC = 64 * KCH, NVI = DV / 64;
    int tid = threadIdx.x; asm volatile("" : "+v"(tid));
    const int lane = tid & 63, r32 = lane & 31, hi = lane >> 5;
    const int rowsw = (r32 & 0x13) | ((r32 & 4) << 1) | ((r32 & 8) >> 1);
    const int kc0 = tid, kc1 = tid + 512; const bool k1v = kc1 < NKC;
    typedef __attribute__((address_space(1))) const char gcc_t;
    gcc_t* Kgb = (gcc_t*)Kg; gcc_t* Vgb = (gcc_t*)Vg;
    const unsigned ko0 = (unsigned)((kc0 / KCH) * DQK + (kc0 % KCH) * 8) * 2u; const int kl0 = (kc0 / KCH) * KSTR + (kc0 % KCH) * 16;
    const unsigned ko1 = (unsigned)((kc1 / KCH) * DQK + (kc1 % KCH) * 8) * 2u; const int kl1 = (kc1 / KCH) * KSTR + (kc1 % KCH) * 16;
    unsigned vo[NVI]; int vl[NVI];
#pragma unroll
    for (int i = 0; i < NVI; ++i) { const int c = tid + 512 * i, d = c >> 3, vc = c & 7; vo[i] = (unsigned)(d * vstride + vc * 8) * 2u; vl[i] = KB + d * VSTR + vc * 16; }
    u32x4 kreg0, kreg1 = {0u, 0u, 0u, 0u}, vreg[NVI];
#define ATT_LOAD(t) do { gcc_t* kt_ = Kgb + (size_t)(t) * 64 * DQK * 2; gcc_t* vt_ = Vgb + (size_t)(t) * 128; \
        kreg0 = *(const __attribute__((address_space(1))) u32x4*)(kt_ + ko0); if (k1v) kreg1 = *(const __attribute__((address_space(1))) u32x4*)(kt_ + ko1); \
        _Pragma("unroll") for (int i_ = 0; i_ < NVI; ++i_) vreg[i_] = *(const __attribute__((address_space(1))) u32x4*)(vt_ + vo[i_]); } while (0)
#define ATT_STORE(bo) do { *(LAS u32x4*)(lds + (bo) + kl0) = kreg0; if (k1v) *(LAS u32x4*)(lds + (bo) + kl1) = kreg1; \
        _Pragma("unroll") for (int i_ = 0; i_ < NVI; ++i_) *(LAS u32x4*)(lds + (bo) + vl[i_]) = vreg[i_]; } while (0)
    ATT_LOAD(0); ATT_STORE(0); __syncthreads();
    float m = 0.f, l = 0.f; bool shifted = false;
#pragma unroll
    for (int dd = 0; dd < ND; ++dd)
#pragma unroll
        for (int r = 0; r < 16; ++r) o[dd][r] = 0.f;
    for (int t = 0; t < ntile; ++t) {
        const int cur = (t & 1) * BUF;
        if (t + 1 < ntile) ATT_LOAD(t + 1);
        if (t < mynt) { SrcLds<KSTR, VSTR> src{lds + cur + rowsw * KSTR + hi * 16, lds + cur + KB + r32 * VSTR + hi * 16}; attn_tile<NS, ND>(q, o, shifted, m, l, src, min(64, kvlen - 64 * t), hi); }
        if (t + 1 < ntile) ATT_STORE(((t + 1) & 1) * BUF);
        __syncthreads();
    }
#undef ATT_LOAD
#undef ATT_STORE
    lsum = half_sum(l);
}
template <int ND>
__device__ __forceinline__ void attn_store(const f32x16 (&o)[ND], float lsum, bf16* orow, int hi, bool valid) {
    const float inv = 1.0f / lsum;
    if (valid) {
#pragma unroll
        for (int dd = 0; dd < ND; ++dd)
#pragma unroll
            for (int rg = 0; rg < 4; ++rg) { u32x2 w; w.x = pk2(o[dd][4 * rg] * inv, o[dd][4 * rg + 1] * inv); w.y = pk2(o[dd][4 * rg + 2] * inv, o[dd][4 * rg + 3] * inv);
                *(u32x2*)(orow + 32 * dd + 8 * rg + 4 * hi) = w; }
    }
}
__device__ __forceinline__ void load_q_mla(bf16x8 (&q)[6], const bf16* qp  , int hi, const float* gqn, const float* gqr, const float* ropep  ) {
    u32x4 raw[6];
#pragma unroll
    for (int s = 0; s < 6; ++s) raw[s] = *(const u32x4*)(qp + 16 * s + 8 * hi);
    float x[6][8];
#pragma unroll
    for (int s = 0; s < 6; ++s) { x[s][0] = bflo(raw[s].x); x[s][1] = bfhi(raw[s].x); x[s][2] = bflo(raw[s].y); x[s][3] = bfhi(raw[s].y);
        x[s][4] = bflo(raw[s].z); x[s][5] = bfhi(raw[s].z); x[s][6] = bflo(raw[s].w); x[s][7] = bfhi(raw[s].w); }
    float ss = 0.f, sr = 0.f;
#pragma unroll
    for (int s = 0; s < 4; ++s)
#pragma unroll
        for (int j = 0; j < 8; ++j) ss += x[s][j] * x[s][j];
#pragma unroll
    for (int j = 0; j < 8; ++j) sr += x[4][j] * x[4][j] + x[5][j] * x[5][j];
    ss = half_sum(ss); sr = half_sum(sr);
    const float rs = rsqrtf(ss * (1.0f / 64.0f) + EPS) * SC_MLA, rr = rsqrtf(sr * (1.0f / 32.0f) + EPS);
#pragma unroll
    for (int s = 0; s < 4; ++s)
#pragma unroll
        for (int j = 0; j < 8; ++j) x[s][j] *= rs * gqn[16 * s + 8 * hi + j];
#pragma unroll
    for (int j = 0; j < 8; ++j) { const int i = 8 * hi + j; const float a1 = x[4][j] * rr * gqr[i], a2 = x[5][j] * rr * gqr[16 + i];
        const float c = ropep[2 * i], sn = ropep[2 * i + 1]; x[4][j] = (a1 * c - a2 * sn) * SC_MLA; x[5][j] = (a1 * sn + a2 * c) * SC_MLA; }
#pragma unroll
    for (int s = 0; s < 6; ++s) { u32x4 w; w.x = pk2(x[s][0], x[s][1]); w.y = pk2(x[s][2], x[s][3]); w.z = pk2(x[s][4], x[s][5]); w.w = pk2(x[s][6], x[s][7]); q[s] = __builtin_bit_cast(bf16x8, w); }
}
__device__ __forceinline__ void load_q_mem(bf16x8 (&q)[8], const bf16* qp  , int hi, const float* gq) {
    u32x4 raw[8];
#pragma unroll
    for (int s = 0; s < 8; ++s) raw[s] = *(const u32x4*)(qp + 16 * s + 8 * hi);
    float ss = 0.f;
#pragma unroll
    for (int s = 0; s < 8; ++s) { const float a0 = bflo(raw[s].x), a1 = bfhi(raw[s].x), a2 = bflo(raw[s].y), a3 = bfhi(raw[s].y), a4 = bflo(raw[s].z), a5 = bfhi(raw[s].z), a6 = bflo(raw[s].w), a7 = bfhi(raw[s].w);
        ss += (a0 * a0 + a1 * a1) + (a2 * a2 + a3 * a3) + (a4 * a4 + a5 * a5) + (a6 * a6 + a7 * a7); }
    ss = half_sum(ss);
    const float rs = rsqrtf(ss * (1.0f / 128.0f) + EPS) * SC_MEM;
#pragma unroll
    for (int s = 0; s < 8; ++s) { const float* g = gq + 16 * s + 8 * hi; u32x4 w;
        w.x = pk2(bflo(raw[s].x) * rs * g[0], bfhi(raw[s].x) * rs * g[1]); w.y = pk2(bflo(raw[s].y) * rs * g[2], bfhi(raw[s].y) * rs * g[3]);
        w.z = pk2(bflo(raw[s].z) * rs * g[4], bfhi(raw[s].z) * rs * g[5]); w.w = pk2(bflo(raw[s].w) * rs * g[6], bfhi(raw[s].w) * rs * g[7]);
        q[s] = __builtin_bit_cast(bf16x8, w); }
}

__device__ __forceinline__ void skinny_gemm(const bf16* A  , const bf16* Bt, int N, int K, const EpiU& E, int gw, int NGW, int lane) {
    const int nwu = N >> 1; const int fr = lane & 15, fq = lane >> 4;
#pragma unroll 1
    for (int wu = gw; wu < nwu; wu += NGW) {
        const int rb = wu & 7, cb = wu >> 3;
        const bf16* ap = A + (size_t)(16 * rb + fr) * K + 8 * fq; const bf16* bp = Bt + (size_t)(16 * cb + fr) * K + 8 * fq;
        pg8::f32x4 acc = {0.f, 0.f, 0.f, 0.f};
        if ((K & 511) == 0) {
#pragma unroll 1
            for (int k0 = 0; k0 < K; k0 += 512) {
                bf16x8 a[16], w[16];
#pragma unroll
                for (int i = 0; i < 16; ++i) { a[i] = *(const bf16x8*)(ap + k0 + 32 * i); w[i] = *(const bf16x8*)(bp + k0 + 32 * i); }
                __builtin_amdgcn_sched_barrier(0);
#pragma unroll
                for (int i = 0; i < 16; ++i) acc = __builtin_amdgcn_mfma_f32_16x16x32_bf16(w[i], a[i], acc, 0, 0, 0);
                __builtin_amdgcn_sched_barrier(0);
            }
        } else {
#pragma unroll 1
            for (int k0 = 0; k0 < K; k0 += 256) {
                bf16x8 a[8], w[8];
#pragma unroll
                for (int i = 0; i < 8; ++i) { a[i] = *(const bf16x8*)(ap + k0 + 32 * i); w[i] = *(const bf16x8*)(bp + k0 + 32 * i); }
                __builtin_amdgcn_sched_barrier(0);
#pragma unroll
                for (int i = 0; i < 8; ++i) acc = __builtin_amdgcn_mfma_f32_16x16x32_bf16(w[i], a[i], acc, 0, 0, 0);
                __builtin_amdgcn_sched_barrier(0);
            }
        }
        const int row = TP + 16 * rb + fr, col = 16 * cb + 4 * fq;
        if (E.mode == 1) {
            bf16* xp = E.xb + (size_t)row * 1024 + col; const u32x2 bw = *(const u32x2*)xp; const f32x4 bs = {bflo(bw.x), bfhi(bw.x), bflo(bw.y), bfhi(bw.y)}; const f32x4 x = bs + acc;
            if (E.out) *(f32x4*)((float*)E.out + (size_t)row * 1024 + col) = x; else { u32x2 wv; wv.x = pk2(x[0], x[1]); wv.y = pk2(x[2], x[3]); *(u32x2*)xp = wv; }
            float s2 = (x[0] * x[0] + x[1] * x[1]) + (x[2] * x[2] + x[3] * x[3]);
            s2 = half_sum(swap16_sum(s2));
            if (fq == 0) unsafeAtomicAdd(E.ssout + row, s2);
        } else {
            const float rs = E.ss ? rsqrtf(E.ss[row] * E.ssdiv + EPS) : 1.0f; f32x4 v = acc * rs;
            if (E.relu2) { v[0] = fmaxf(v[0], 0.f); v[1] = fmaxf(v[1], 0.f); v[2] = fmaxf(v[2], 0.f); v[3] = fmaxf(v[3], 0.f); v = v * v; }
            u32x2 wv; wv.x = pk2(v[0], v[1]); wv.y = pk2(v[2], v[3]); *(u32x2*)((bf16*)E.out + (size_t)row * E.ldc + col) = wv;
        }
    }
}

__device__ __forceinline__ void conv_w(const float* W, int Nsrc, int K, int ndst, int blk, int sblk, int soff, const float* gain, bf16* dst, LAS float* scr, int gw, int NGW, int lane) {
    const int nblk = ndst / 32, nitems = (K / 64) * nblk;
#pragma unroll 1
    for (int it = gw; it < nitems; it += NGW) {
        const int kb = it / nblk, nb = it % nblk, k0 = 64 * kb, n0 = 32 * nb;
        const int sc0 = blk > 0 ? (n0 / blk) * sblk + soff + (n0 % blk)
                                : (((nb >> 3) * 4 + (nb & 3)) * 128 + 32 * ((nb >> 2) & 1));
        float wv[32];
#pragma unroll
        for (int i = 0; i < 32; ++i) wv[i] = W[(size_t)(k0 + 2 * i + (lane >> 5)) * Nsrc + sc0 + (lane & 31)];
        if (gain) {
#pragma unroll
            for (int i = 0; i < 32; ++i) wv[i] *= gain[k0 + 2 * i + (lane >> 5)];
        }
#pragma unroll
        for (int i = 0; i < 32; ++i) scr[(2 * i + (lane >> 5)) * 33 + (lane & 31)] = wv[i];
        asm volatile("s_waitcnt lgkmcnt(0)" ::: "memory");
        const int c = lane & 7;
#pragma unroll
        for (int j = 0; j < 4; ++j) { const int n = (lane >> 3) + 8 * j; const LAS float* s = scr + (8 * c) * 33 + n;
            u32x4 o; o.x = pk2(s[0 * 33], s[1 * 33]); o.y = pk2(s[2 * 33], s[3 * 33]); o.z = pk2(s[4 * 33], s[5 * 33]); o.w = pk2(s[6 * 33], s[7 * 33]);
            *(u32x4*)(dst + (size_t)(n0 + n) * K + k0 + 8 * c) = o; }
        asm volatile("s_waitcnt lgkmcnt(0)" ::: "memory");
    }
}
__device__ __forceinline__ float row_to_bf16(const float* xr, bf16* orow, int lane) {
    f32x4 v[4]; float s = 0.f;
#pragma unroll
    for (int j = 0; j < 4; ++j) { v[j] = ((const f32x4*)xr)[lane + 64 * j]; s += (v[j][0] * v[j][0] + v[j][1] * v[j][1]) + (v[j][2] * v[j][2] + v[j][3] * v[j][3]); }
#pragma unroll
    for (int j = 0; j < 4; ++j) { u32x2 w; w.x = pk2(v[j][0], v[j][1]); w.y = pk2(v[j][2], v[j][3]); ((u32x2*)orow)[lane + 64 * j] = w; }
    return wave_sum(s);
}

#define RLX_AGENT __ATOMIC_RELAXED, __HIP_MEMORY_SCOPE_AGENT
#define XB_TMO      128
#define XB_XCNT(j)  (256  + 64 * (j))
#define XB_XSUB(j)  (1280 + 64 * (j))
#define XB_XGEN(j)  (2304 + 64 * (j))
#define XB_TOP      3328
#define XB_TOPGEN   3392
#define XCD_BAR_WORDS 3456
#define XB_SPIN_CAP (1u << 18)

__device__ __forceinline__ unsigned xb_ld(unsigned* p)              { return __hip_atomic_load(p, __ATOMIC_RELAXED, __HIP_MEMORY_SCOPE_AGENT); }
__device__ __forceinline__ unsigned xb_add(unsigned* p, unsigned v) { return __hip_atomic_fetch_add(p, v, __ATOMIC_RELAXED, __HIP_MEMORY_SCOPE_AGENT); }
__device__ __forceinline__ unsigned xb_xcc_id() { return (unsigned)__builtin_amdgcn_s_getreg((3 << 11) | 20) & 0xFu; }
#define XB_SPIN(cond, bar) do { unsigned _sp = 0; while (cond) { __builtin_amdgcn_s_sleep(1); \
    if ((++_sp & 255u) == 0u) { if (xb_ld(&(bar)[XB_TMO])) break; if (_sp > XB_SPIN_CAP) { atomicAdd(&(bar)[XB_TMO], 1u); break; } } } } while (0)

struct XcdBarrier {
    unsigned* bar; unsigned x;
    volatile LAS unsigned* st;
};

__device__ __forceinline__ XcdBarrier xcd_barrier_post(unsigned* bar, volatile LAS unsigned* st) {
    XcdBarrier b; b.bar = bar; b.x = xb_xcc_id(); b.st = st;
    if (threadIdx.x == 0) (void)xb_add(&bar[XB_XCNT(b.x)], 1u);
    return b;
}
__device__ __forceinline__ void xcd_barrier_complete(unsigned* bar, unsigned x, unsigned& nloc, unsigned& nx) {
    const unsigned G = gridDim.x * gridDim.y * gridDim.z;
    unsigned sum, cnt, mine, sp = 0u;
    for (;;) {
        sum = 0u; cnt = 0u; mine = 0u;
#pragma unroll
        for (unsigned j = 0; j < 16; ++j) { const unsigned c = xb_ld(&bar[XB_XCNT(j)]); sum += c; cnt += (c > 0u) ? 1u : 0u; mine = (j == x) ? c : mine; }
        if (sum == G) break;
        __builtin_amdgcn_s_sleep(1);
        if ((++sp & 255u) == 0u) { if (xb_ld(&bar[XB_TMO])) break; if (sp > XB_SPIN_CAP) { atomicAdd(&bar[XB_TMO], 1u); break; } }
    }
    nloc = mine > 0u ? mine : 1u; nx = cnt > 0u ? cnt : 1u;
}

__device__ __forceinline__ void xcd_barrier(const XcdBarrier& b) {
    asm volatile("s_waitcnt vmcnt(0)" ::: "memory");
    __syncthreads();
    if (threadIdx.x == 0) {
        unsigned* bar = b.bar;
        __builtin_amdgcn_s_waitcnt(0);
        unsigned nloc = b.st[0], nx = b.st[1];
        if (nloc == 0u) { xcd_barrier_complete(bar, b.x, nloc, nx); b.st[0] = nloc; b.st[1] = nx; }
        const unsigned old = xb_add(&bar[XB_XSUB(b.x)], 1u);
        const unsigned gen = old / nloc;
        if (old + 1u == (gen + 1u) * nloc) {
            __builtin_amdgcn_fence(__ATOMIC_RELEASE, "agent");
            asm volatile("s_waitcnt vmcnt(0)" ::: "memory");
            const unsigned og = xb_add(&bar[XB_TOP], 1u);
            const unsigned tg = og / nx;
            if (og + 1u == (tg + 1u) * nx) xb_add(&bar[XB_TOPGEN], 1u);
            else XB_SPIN(xb_ld(&bar[XB_TOPGEN]) == tg, bar);
            __builtin_amdgcn_fence(__ATOMIC_ACQUIRE, "agent");
            xb_add(&bar[XB_XGEN(b.x)], 1u);
            asm volatile("s_waitcnt vmcnt(0)" ::: "memory");
        } else {
            XB_SPIN(xb_ld(&bar[XB_XGEN(b.x)]) == gen, bar);
            __builtin_amdgcn_fence(__ATOMIC_ACQUIRE, "agent");
            asm volatile("s_waitcnt vmcnt(0)" ::: "memory");
        }
    }
    __syncthreads();
}


#define SS ((float*)(ws + OFF_SS))
#define MSS ((float*)(ws + OFF_MSS))
#define ROPE ((float*)(ws + OFF_ROPE))
#define WMKV ((bf16*)(ws + OFF_WMKV))
#define MEMB ((bf16*)(ws + OFF_MEMB))
#define MKVRAW ((float*)(ws + OFF_MKVRAW))
#define MK ((bf16*)(ws + OFF_MK))
#define MVT ((bf16*)(ws + OFF_MVT))
#define XB ((bf16*)(ws + OFF_XB))
#define LATC ((bf16*)(ws + OFF_LATC))
#define KR ((bf16*)(ws + OFF_KR))
#define UG ((bf16*)(ws + OFF_UG))
#define VG ((bf16*)(ws + OFF_VG))
#define Zb ((bf16*)(ws + OFF_Z))
#define CQ ((bf16*)(ws + OFF_CQ))
#define Hb ((bf16*)(ws + OFF_H))
#define QRAW ((bf16*)(ws + OFF_QRAW))
#define KRAW ((bf16*)(ws + OFF_KRAW))
#define QMRAW ((bf16*)(ws + OFF_QMRAW))
#define OM ((bf16*)(ws + OFF_OM))
#define VT ((bf16*)(ws + OFF_VT))
#define KH ((bf16*)(ws + OFF_KH))
#define KHS ((bf16*)(ws + OFF_KHS))
#define MIX ((bf16*)(ws + OFF_MIX))
#define HID ((bf16*)(ws + OFF_HID))
#ifndef EN_PRO
#define EN_PRO 1
#endif
#ifndef EN_GEMM
#define EN_GEMM 1
#endif
#ifndef EN_E1
#define EN_E1 1
#endif
#ifndef EN_E2
#define EN_E2 1
#endif
#ifndef EN_KB
#define EN_KB 1
#endif
#ifndef EN_ATT
#define EN_ATT 1
#endif
#ifndef EN_MATT
#define EN_MATT 1
#endif
__global__ void __launch_bounds__(512, 2) fwd_kernel(Params P) {
    extern __shared__ __attribute__((aligned(16))) unsigned char lds_raw[];
    LAS unsigned char* lds = (LAS unsigned char*)lds_raw;
    LAS char* ldc_ = (LAS char*)lds_raw;
    const int G = gridDim.x;
    float* dout = P.out;
    cg::grid_group grid = cg::this_grid();
    volatile LAS unsigned* MISC = (volatile LAS unsigned*)(lds + 131072 + 320);
    if (threadIdx.x < 32) MISC[threadIdx.x] = 0u;
    __syncthreads();
    XcdBarrier bar; bar.bar = (unsigned*)(P.ws + OFF_CTL); bar.x = 0; bar.st = MISC + 8;
    if (P.ph_hi - P.ph_lo > 1) bar = xcd_barrier_post((unsigned*)(P.ws + OFF_CTL), MISC + 8);

#ifndef REPEAT_SP
#define REPEAT_SP 0
#endif
#ifndef DOUBLE_SYNC
#define DOUBLE_SYNC 0
#endif
    int redone = 0; (void)redone;
#pragma unroll 1
    for (int ph = P.ph_lo; ph < P.ph_hi; ++ph) {
        int bid = blockIdx.x; asm volatile("" : "+s"(bid));
        unsigned char* ws = P.ws; asm volatile("" : "+s"(ws));
        const int NGW = G * 8, GT = G * 512;
#define PHASE_IDS int tid = threadIdx.x; asm volatile("" : "+v"(tid)); const int lane = tid & 63, wid = __builtin_amdgcn_readfirstlane(tid >> 6); const int gw = bid * 8 + wid, gtid = bid * 512 + tid; (void)gw; (void)gtid; (void)lane;
        const int l = (ph - 1) / 11, sp = (ph == 0) ? 0 : ((ph - 1) % 11) + 1;
        if (sp == 4 && !(REPEAT_SP == 4)) continue;
        unsigned char* wl = ws + OFF_W + (size_t)l * W_LAYER;
#define WIN ((bf16*)(wl + W_WIN))
#define WUQ ((bf16*)(wl + W_WUQ))
#define WK ((bf16*)(wl + W_WK))
#define WVT ((bf16*)(wl + W_WVT))
#define WOUT ((bf16*)(wl + W_WOUT))
#define WMQ ((bf16*)(wl + W_WMQ))
#define WMO ((bf16*)(wl + W_WMO))
#define WFF1 ((bf16*)(wl + W_FF1))
#define WFF2 ((bf16*)(wl + W_FF2))
#define SS1 (SS + (size_t)(3 * l) * TT)
#define SS2 (SS + (size_t)(3 * l + 1) * TT)
#define SS3 (SS + (size_t)(3 * l + 2) * TT)
#define SS1n (SS + (size_t)(3 * ((l + 1) & 1)) * TT)

        if (sp == 0 && EN_PRO) {
            PHASE_IDS
            LAS float* scr = (LAS float*)(lds + wid * 16384);
            int rot = 0;
#define CONVW(src, Nsrc, K, ndst, blk, sblk, soff, gain, dst) do { int gwr = gw - rot % NGW; if (gwr < 0) gwr += NGW; conv_w(src, Nsrc, K, ndst, blk, sblk, soff, gain, dst, scr, gwr, NGW, lane); rot += ((K) / 64) * ((ndst) / 32); } while (0)
#pragma unroll 1
            for (int ll = 0; ll < 2; ++ll) {
                unsigned char* w2 = ws + OFF_W + (size_t)ll * W_LAYER;
                CONVW(P.in[35] + (size_t)ll * 1024 * 4096, 4096, 1024, 4096, 4096, 4096, 0, P.in[34] + ll * 1024, (bf16*)(w2 + W_FF1));
                CONVW(P.in[36] + (size_t)ll * 4096 * 1024, 1024, 4096, 1024, 1024, 1024, 0, nullptr, (bf16*)(w2 + W_FF2));
                CONVW(P.in[9] + (size_t)ll * 1024 * 1440, 1440, 1024, 1440, 1440, 1440, 0, P.in[8] + ll * 1024, (bf16*)(w2 + W_WIN));
                CONVW(P.in[18] + (size_t)ll * 256 * 768, 768, 256, 768, 768, 768, 0, P.in[17] + ll * 256, (bf16*)(w2 + W_WUQ));
                CONVW(P.in[20] + (size_t)ll * 128 * 1024, 1024, 128, 512, -1, 128, 0, nullptr, (bf16*)(w2 + W_WK));
                CONVW(P.in[20] + (size_t)ll * 128 * 1024, 1024, 128, 512, 64, 128, 64, nullptr, (bf16*)(w2 + W_WVT));
                CONVW(P.in[25] + (size_t)ll * 1024 * 1024, 1024, 1024, 1024, 1024, 1024, 0, nullptr, (bf16*)(w2 + W_WOUT));
                CONVW(P.in[28] + (size_t)ll * 1024 * 512, 512, 1024, 512, 512, 512, 0, P.in[26] + ll * 1024, (bf16*)(w2 + W_WMQ));
                CONVW(P.in[29] + (size_t)ll * 1024 * 512, 512, 1024, 512, 512, 512, 0, P.in[27] + ll * 1024, WMKV + (size_t)(ll * 1024) * 1024);
                CONVW(P.in[30] + (size_t)ll * 1024 * 512, 512, 1024, 512, 512, 512, 0, P.in[27] + ll * 1024, WMKV + (size_t)(ll * 1024 + 512) * 1024);
                CONVW(P.in[31] + (size_t)ll * 512 * 1024, 1024, 512, 1024, 1024, 1024, 0, nullptr, (bf16*)(w2 + W_WMO));
#pragma unroll 1
                for (int i = gtid; i < 96 * 1024 / 8; i += GT) ((u32x4*)((bf16*)(w2 + W_WIN) + (size_t)1440 * 1024))[i] = (u32x4){0u, 0u, 0u, 0u};
            }
#pragma unroll 1
            for (int lb = 0; lb < 16; ++lb) { const int ll = lb >> 3, b2 = lb & 7;
                CONVW(P.in[7] + (size_t)(ll * 8 + b2) * 256 * 512, 512, 256, 512, 512, 512, 0, nullptr, MVT + (size_t)((ll * 12 + 4 + b2) * 4) * 128 * 256); }
#undef CONVW
#pragma unroll 1
            for (int row = gw; row < TV; row += 2 * NGW) {
                const int row2 = row + NGW; const bool has2 = row2 < TV;
                const float* xr = row < TP ? P.in[0] + (size_t)row * 1024 : P.in[1] + (size_t)(row - TP) * 1024;
                const float* xr2 = !has2 ? xr : row2 < TP ? P.in[0] + (size_t)row2 * 1024 : P.in[1] + (size_t)(row2 - TP) * 1024;
                f32x4 va[4], vb[4];
#pragma unroll
                for (int j = 0; j < 4; ++j) { va[j] = ((const f32x4*)xr)[lane + 64 * j]; vb[j] = ((const f32x4*)xr2)[lane + 64 * j]; }
                float sa = 0.f, sb = 0.f;
#pragma unroll
                for (int j = 0; j < 4; ++j) { sa += (va[j][0] * va[j][0] + va[j][1] * va[j][1]) + (va[j][2] * va[j][2] + va[j][3] * va[j][3]);
                    sb += (vb[j][0] * vb[j][0] + vb[j][1] * vb[j][1]) + (vb[j][2] * vb[j][2] + vb[j][3] * vb[j][3]);
                    u32x2 w; w.x = pk2(va[j][0], va[j][1]); w.y = pk2(va[j][2], va[j][3]); ((u32x2*)(XB + (size_t)row * 1024))[lane + 64 * j] = w;
                    if (has2) { w.x = pk2(vb[j][0], vb[j][1]); w.y = pk2(vb[j][2], vb[j][3]); ((u32x2*)(XB + (size_t)row2 * 1024))[lane + 64 * j] = w; } }
                sa = wave_sum(sa); sb = wave_sum(sb);
                if (lane == 0) { SS[row] = sa; if (has2) SS[row2] = sb; }
            }
            { int i = TV + gtid; while (i < 6 * TT) { SS[i] = 0.f; i += GT; asm volatile("" : "+v"(i)); } }
#pragma unroll 1
            for (int row = gw; row < 1024; row += NGW) { const float s = row_to_bf16(P.in[2] + (size_t)row * 1024, MEMB + (size_t)row * 1024, lane); if (lane == 0) MSS[row] = s; }
#pragma unroll 1
            for (int it = gw; it < 16 * 128; it += NGW) {
                const int k = it & 15, pos = (it >> 4) * 64 + lane, k3 = k & 3, k2 = k >> 2;
                const double b0 = k3 == 0 ? 1.0 : k3 == 1 ? 0.5623413251903491 : k3 == 2 ? 0.31622776601683794 : 0.1778279410038923;
                const double d0 = k2 == 0 ? 1.0 : k2 == 1 ? 0.1 : k2 == 2 ? 0.01 : 0.001;
                const double ang = (double)pos * (b0 * d0);
                const double kk = __builtin_rint(ang * 0.15915494309189535);
                const float r = (float)(ang - kk * 6.283185307179586);
                ROPE[2 * (pos * 16 + k)] = cosf(r); ROPE[2 * (pos * 16 + k) + 1] = sinf(r);
            }
#pragma unroll 1
            for (int row = gw; row < 2 * 8 * 256; row += NGW) {
                const int ll = row >> 11, b = (row >> 8) & 7, mm = row & 255, h = lane >> 4, d0 = 8 * (lane & 15);
                const float* ks = P.in[6] + (size_t)row * 512 + 8 * lane;
                const f32x4 k0 = *(const f32x4*)ks, k1 = *(const f32x4*)(ks + 4);
                u32x4 w; w.x = pk2(k0[0], k0[1]); w.y = pk2(k0[2], k0[3]); w.z = pk2(k1[0], k1[1]); w.w = pk2(k1[2], k1[3]);
                *(u32x4*)(MK + ((size_t)((ll * 12 + 4 + b) * 4 + h) * 256 + mm) * 128 + d0) = w;
            }
            __syncthreads();
        }

        {
            const int ng = !EN_GEMM ? 0 : (sp == 1) ? (l == 0 ? 2 : 1) : (sp == 3) ? 3 : (sp == 6 || sp == 7 || sp == 9 || sp == 10 || sp == 11) ? 1 : 0;
#pragma unroll 1
            for (int gi = 0; gi < ng; ++gi) {
                pg8::Gemm g; bool sk = true; EpiU E; E.mode = 0; E.relu2 = 0; E.out = nullptr; E.ldc = 0; E.ss = nullptr; E.ssdiv = 1.0f / 1024.0f; E.ssout = nullptr; E.base_p = nullptr; E.base_s = nullptr; E.xb = nullptr; E.gkn = nullptr; E.kr = nullptr; E.kh = nullptr; E.khs = nullptr;
                if (sp == 1 && gi == 0) { g = pg8::Gemm{XB, WIN, TP, 1536, 1024}; E.out = Hb; E.ldc = 1536; E.ss = SS1; }
                else if (sp == 1) { g = pg8::Gemm{MEMB, WMKV, 1024, 2048, 1024}; sk = false; E.mode = 2; E.out = MKVRAW; E.ldc = 2048; E.ss = MSS; }
                else if (sp == 3 && gi == 0) { g = pg8::Gemm{CQ, WUQ, TP, 768, 256}; E.out = QRAW; E.ldc = 768; }
                else if (sp == 3 && gi == 1) { g = pg8::Gemm{LATC, WK, LR, 512, 128}; sk = false; E.mode = 3; E.gkn = P.in[23] + l * 64; E.kr = KR; E.kh = KH; E.khs = KHS; }
                else if (sp == 3) { g = pg8::Gemm{WVT, LATC, 512, LR, 128}; sk = false; E.out = VT; E.ldc = LR; }
                else if (sp == 6) { g = pg8::Gemm{MIX, WOUT, TP, 1024, 1024}; E.mode = 1; E.out = nullptr; E.ldc = 1024; E.ssout = SS2; E.xb = XB; }
                else if (sp == 7) { g = pg8::Gemm{XB, WMQ, TP, 512, 1024}; E.out = QMRAW; E.ldc = 512; E.ss = SS2; }
                else if (sp == 9) { g = pg8::Gemm{OM, WMO, TP, 1024, 512}; E.mode = 1; E.out = nullptr; E.ldc = 1024; E.ssout = SS3; E.xb = XB; }
                else if (sp == 10) { g = pg8::Gemm{XB, WFF1, TP, 4096, 1024}; E.out = HID; E.ldc = 4096; E.ss = SS3; E.relu2 = 1; }
                else { g = pg8::Gemm{HID, WFF2, TP, 1024, 4096}; E.mode = 1; E.out = l == 1 ? dout : nullptr; E.ldc = 1024; E.ssout = SS1n; E.xb = XB; }
                const int rotc = (sp == 3 && (G & 7) == 0) ? (bid + G - (gi == 1 ? G / 2 : gi == 2 ? (3 * G) / 4 : 0)) % G : bid;
                pg8::StaticOrder S; S.init(g.M, g.N, G, rotc);
                if (E.mode != 2) { EpiP Ep; Ep.mode = E.mode; Ep.relu2 = E.relu2; Ep.out = E.out; Ep.ldc = E.ldc; Ep.ss = E.ss; Ep.ssdiv = E.ssdiv; Ep.ssout = E.ssout; Ep.xb = E.xb;
                    Ep.gkn = E.gkn; Ep.kr = E.kr; Ep.kh = E.kh; Ep.khs = E.khs;
                    pg8::gemm_phase<EpiP, pg8::StaticOrder, true, true>(lds, g, S, Ep); }
                else pg8::gemm_phase<EpiU, pg8::StaticOrder, true, true>(lds, g, S, E);
                __syncthreads();
                if (sk) { PHASE_IDS skinny_gemm(g.A + (size_t)TP * g.K, g.Bt, g.N, g.K, E, gw, NGW, lane); }
            }
        }

        if (sp == 2 && EN_E1) {
            PHASE_IDS
            const float* g_a = P.in[10] + l * 256; const float* g_kva = P.in[19] + l * 128; const float* g_kr = P.in[24] + l * 32;
            const f32x4 gA = *(const f32x4*)(g_a + 4 * lane), gKVA = *(const f32x4*)(g_kva + 4 * (lane & 31)), gKR = *(const f32x4*)(g_kr + 4 * (lane & 7));
            u32x2 cu = {0u, 0u}, cv = {0u, 0u}, ca = {0u, 0u}, cg_ = {0u, 0u}, cq = {0u, 0u}, cl = {0u, 0u}, ck = {0u, 0u};
            u32x2 nu = {0u, 0u}, nv = {0u, 0u}, na = {0u, 0u}, ng_ = {0u, 0u}, nq = {0u, 0u}, nl = {0u, 0u}, nk = {0u, 0u};
            if (gw < TV) { const bf16* h_ = Hb + (size_t)gw * 1536 + 4 * lane; cu = *(const u32x2*)(h_); cv = *(const u32x2*)(h_ + 256); ca = *(const u32x2*)(h_ + 512);
                cg_ = *(const u32x2*)(h_ + 768); cq = *(const u32x2*)(h_ + 1024); if (lane < 32) cl = *(const u32x2*)(h_ + 1280); if (lane < 8) ck = *(const u32x2*)(h_ + 1408); }
#pragma unroll 1
            for (int row = gw; row < TV; row += NGW) {
                if (row + NGW < TV) { const bf16* h_ = Hb + (size_t)(row + NGW) * 1536 + 4 * lane; nu = *(const u32x2*)(h_); nv = *(const u32x2*)(h_ + 256); na = *(const u32x2*)(h_ + 512);
                    ng_ = *(const u32x2*)(h_ + 768); nq = *(const u32x2*)(h_ + 1024); if (lane < 32) nl = *(const u32x2*)(h_ + 1280); if (lane < 8) nk = *(const u32x2*)(h_ + 1408); }
                const bool samp = row >= TP;
                int b, t; if (!samp) { b = row >> 13; t = row & 8191; } else { b = (row - TP) >> 4; t = (row - TP) & 15; }
                const int pos = samp ? 1024 + t : t; const int c4 = 4 * lane;
                const float* rp = ROPE + (size_t)pos * 32 + 8 * (lane & 3); const f32x4 cs0 = *(const f32x4*)rp, cs1 = *(const f32x4*)(rp + 4);
                {
                    const u32x2 r = cu; u32x2 w; w.x = pk2(gelu_f(bflo(r.x)), gelu_f(bfhi(r.x))); w.y = pk2(gelu_f(bflo(r.y)), gelu_f(bfhi(r.y)));
                    *(u32x2*)(UG + (size_t)row * 256 + c4) = w; }
                {
                    const u32x2 r = cv; float v0 = gelu_f(bflo(r.x)), v1 = gelu_f(bfhi(r.x)), v2 = gelu_f(bflo(r.y)), v3 = gelu_f(bfhi(r.y));
                    const float rs = rsqrtf(wave_sum((v0 * v0 + v1 * v1) + (v2 * v2 + v3 * v3)) * (1.0f / 256.0f) + EPS); const f32x4 g = gA;
                    v0 *= rs * g[0]; v1 *= rs * g[1]; v2 *= rs * g[2]; v3 *= rs * g[3];
                    u32x2 w; w.x = pk2(v0, v1); w.y = pk2(v2, v3); *(u32x2*)(VG + (size_t)row * 256 + c4) = w;
                    if (samp) *(f32x4*)(dout + O_GVS + ((size_t)(l * 8 + b) * 16 + t) * 256 + c4) = (f32x4){v0, v1, v2, v3}; }
                {
                    const u32x2 a = ca, gt = cg_;
                    const float z0 = bflo(a.x) * sigm_f(bflo(gt.x)), z1 = bfhi(a.x) * sigm_f(bfhi(gt.x)), z2 = bflo(a.y) * sigm_f(bflo(gt.y)), z3 = bfhi(a.y) * sigm_f(bfhi(gt.y));
                    u32x2 w; w.x = pk2(z0, z1); w.y = pk2(z2, z3); *(u32x2*)(Zb + (size_t)row * 256 + c4) = w;
                    if (!samp) { if (t >= 8162) *(f32x4*)(dout + O_CONVP + ((size_t)(l * 4 + b) * 30 + (t - 8162)) * 256 + c4) = (f32x4){z0, z1, z2, z3}; }
                    else { *(f32x4*)(dout + O_CONVS + ((size_t)(l * 8 + b) * 30 + 14 + t) * 256 + c4) = (f32x4){z0, z1, z2, z3};
                           if (t < 14) *(f32x4*)(dout + O_CONVS + ((size_t)(l * 8 + b) * 30 + t) * 256 + c4) = *(const f32x4*)(P.in[5] + ((size_t)(l * 8 + b) * 30 + 16 + t) * 256 + c4); } }
                {
                    const u32x2 r = cq; float v0 = bflo(r.x), v1 = bfhi(r.x), v2 = bflo(r.y), v3 = bfhi(r.y);
                    const float rs = rsqrtf(wave_sum((v0 * v0 + v1 * v1) + (v2 * v2 + v3 * v3)) * (1.0f / 256.0f) + EPS);
                    u32x2 w; w.x = pk2(v0 * rs, v1 * rs); w.y = pk2(v2 * rs, v3 * rs); *(u32x2*)(CQ + (size_t)row * 256 + c4) = w; }
                const size_t lrow = samp ? (size_t)TP + b * SKV + 1024 + t : (size_t)row;
                {
                    float v0 = 0.f, v1 = 0.f, v2 = 0.f, v3 = 0.f;
                    if (lane < 32) { const u32x2 r = cl; v0 = bflo(r.x); v1 = bfhi(r.x); v2 = bflo(r.y); v3 = bfhi(r.y); }
                    const float rs = rsqrtf(wave_sum((v0 * v0 + v1 * v1) + (v2 * v2 + v3 * v3)) * (1.0f / 128.0f) + EPS);
                    if (lane < 32) { const f32x4 g = gKVA; v0 *= rs * g[0]; v1 *= rs * g[1]; v2 *= rs * g[2]; v3 *= rs * g[3];
                        float* op = samp ? dout + O_LATS + ((size_t)(l * 8 + b) * 16 + t) * 128 : dout + O_LATP + ((size_t)(l * 4 + b) * 8192 + t) * 128;
                        *(f32x4*)(op + c4) = (f32x4){v0, v1, v2, v3}; u32x2 w; w.x = pk2(v0, v1); w.y = pk2(v2, v3); *(u32x2*)(LATC + lrow * 128 + c4) = w; } }
                {
                    float v0 = 0.f, v1 = 0.f, v2 = 0.f, v3 = 0.f;
                    if (lane < 8) { const u32x2 r = ck; v0 = bflo(r.x); v1 = bfhi(r.x); v2 = bflo(r.y); v3 = bfhi(r.y); }
                    const float rs = rsqrtf(wave_sum((v0 * v0 + v1 * v1) + (v2 * v2 + v3 * v3)) * (1.0f / 32.0f) + EPS);
                    if (lane < 8) { const f32x4 g = gKR; v0 *= rs * g[0]; v1 *= rs * g[1]; v2 *= rs * g[2]; v3 *= rs * g[3]; }
#define XOR4(v) __builtin_bit_cast(float, __builtin_amdgcn_ds_bpermute((lane ^ 4) << 2, __builtin_bit_cast(int, (v))))
                    const float o0 = XOR4(v0), o1 = XOR4(v1), o2 = XOR4(v2), o3 = XOR4(v3);
#undef XOR4
                    if (lane < 8) {
                        float r0, r1, r2, r3;
                        if (lane < 4) { r0 = v0 * cs0[0] - o0 * cs0[1]; r1 = v1 * cs0[2] - o1 * cs0[3]; r2 = v2 * cs1[0] - o2 * cs1[1]; r3 = v3 * cs1[2] - o3 * cs1[3]; }
                        else          { r0 = o0 * cs0[1] + v0 * cs0[0]; r1 = o1 * cs0[3] + v1 * cs0[2]; r2 = o2 * cs1[1] + v2 * cs1[0]; r3 = o3 * cs1[3] + v3 * cs1[2]; }
                        float* op = samp ? dout + O_KRS + ((size_t)(l * 8 + b) * 16 + t) * 32 : dout + O_KRP + ((size_t)(l * 4 + b) * 8192 + t) * 32;
                        *(f32x4*)(op + c4) = (f32x4){r0, r1, r2, r3}; u32x2 w; w.x = pk2(r0, r1); w.y = pk2(r2, r3); *(u32x2*)(KR + lrow * 32 + c4) = w; } }
                cu = nu; cv = nv; ca = na; cg_ = ng_; cq = nq; cl = nl; ck = nk;
            }
#pragma unroll 1
            for (int i = gtid; i < 8 * 1024 * 16; i += GT) { const int b = i >> 14, t = (i >> 4) & 1023, c = i & 15;
                const float* s = P.in[3] + ((size_t)(l * 8 + b) * 1024 + t) * 128 + 8 * c; const f32x4 a = *(const f32x4*)s, bb = *(const f32x4*)(s + 4);
                u32x4 w; w.x = pk2(a[0], a[1]); w.y = pk2(a[2], a[3]); w.z = pk2(bb[0], bb[1]); w.w = pk2(bb[2], bb[3]);
                *(u32x4*)(LATC + ((size_t)TP + b * SKV + t) * 128 + 8 * c) = w; }
#pragma unroll 1
            for (int i = gtid; i < 8 * 1024 * 4; i += GT) { const int b = i >> 12, t = (i >> 2) & 1023, c = i & 3;
                const float* s = P.in[4] + ((size_t)(l * 8 + b) * 1024 + t) * 32 + 8 * c; const f32x4 a = *(const f32x4*)s, bb = *(const f32x4*)(s + 4);
                u32x4 w; w.x = pk2(a[0], a[1]); w.y = pk2(a[2], a[3]); w.z = pk2(bb[0], bb[1]); w.w = pk2(bb[2], bb[3]);
                *(u32x4*)(KR + ((size_t)TP + b * SKV + t) * 32 + 8 * c) = w; }
            if (l == 0) {
#pragma unroll 1
                for (int it = gw; it < 2048; it += NGW) { const int ll = it >> 10, row = it & 1023, b = row >> 8, mm = row & 255, h = lane >> 4, d0 = 8 * (lane & 15);
                    const float* kp = MKVRAW + (size_t)row * 2048 + ll * 1024 + 8 * lane; const float* vp = kp + 512;
                    f32x4 k0 = *(const f32x4*)kp, k1 = *(const f32x4*)(kp + 4); const f32x4 v0 = *(const f32x4*)vp, v1 = *(const f32x4*)(vp + 4);
                    float s = (k0[0] * k0[0] + k0[1] * k0[1]) + (k0[2] * k0[2] + k0[3] * k0[3]) + (k1[0] * k1[0] + k1[1] * k1[1]) + (k1[2] * k1[2] + k1[3] * k1[3]);
                    s = sum16(s);
                    const float rs = rsqrtf(s * (1.0f / 128.0f) + EPS); const float* gk = P.in[33] + ll * 128 + d0;
                    const f32x4 g0 = *(const f32x4*)gk, g1 = *(const f32x4*)(gk + 4); k0 = k0 * rs * g0; k1 = k1 * rs * g1;
                    float* ok = dout + O_MKP + ((size_t)(ll * 4 + b) * 256 + mm) * 512 + 8 * lane; float* ov = dout + O_MVP + ((size_t)(ll * 4 + b) * 256 + mm) * 512 + 8 * lane;
                    *(f32x4*)ok = k0; *(f32x4*)(ok + 4) = k1; *(f32x4*)ov = v0; *(f32x4*)(ov + 4) = v1;
                    u32x4 w; w.x = pk2(k0[0], k0[1]); w.y = pk2(k0[2], k0[3]); w.z = pk2(k1[0], k1[1]); w.w = pk2(k1[2], k1[3]);
                    *(u32x4*)(MK + ((size_t)((ll * 12 + b) * 4 + h) * 256 + mm) * 128 + d0) = w;
                }
                LAS float* scr = (LAS float*)(lds + wid * 16384);
#pragma unroll 1
                for (int lb = 0; lb < 8; ++lb) { const int ll = lb >> 2, b2 = lb & 3; int gwr = gw - (lb * 64) % NGW; if (gwr < 0) gwr += NGW;
                    conv_w(MKVRAW + (size_t)(b2 * 256) * 2048 + ll * 1024 + 512, 2048, 256, 512, 512, 512, 0, nullptr, MVT + (size_t)((ll * 12 + b2) * 4) * 128 * 256, scr, gwr, NGW, lane); }
            }
        }

        if (sp == 3 && EN_E2) {
            PHASE_IDS
            constexpr int GV_OFF = 128 * 272;
#pragma unroll 1
            for (int g = 0; g < 4; ++g) {
                const float* wsg = P.in[11] + ((size_t)(l * 4 + g) * 128) * 128; const float* bsg = P.in[12] + (l * 4 + g) * 128;
#pragma unroll 1
                for (int c = tid; c < 128 * 16; c += 512) { const int i = c >> 4, j0 = (c & 15) * 8; const f32x4 a = *(const f32x4*)(wsg + i * 128 + j0), b2 = *(const f32x4*)(wsg + i * 128 + j0 + 4);
                    float e[8] = {a[0], a[1], a[2], a[3], b2[0], b2[1], b2[2], b2[3]};
#pragma unroll
                    for (int k = 0; k < 8; ++k) if (j0 + k > i) e[k] = 0.f;
                    u32x4 w; w.x = pk2(e[0], e[1]); w.y = pk2(e[2], e[3]); w.z = pk2(e[4], e[5]); w.w = pk2(e[6], e[7]);
                    *(LAS u32x4*)(lds + i * 272 + j0 * 2) = w; }
#pragma unroll 1
                for (int u = bid; u < 256 + 256; u += G) {
                    if (u >= 256 && !(G == 256 ? (u - 256 >= 224 && ((u - 256 - 224) >> 3) == g) : (u - 256 < 8))) continue;
                    const int row0 = u < 256 ? 128 * u : TP + 16 * ((u - 256) & 7), nrows = u < 256 ? 128 : 16;
#pragma unroll 1
                    for (int c = tid; c < 128 * 16; c += 512) { const int j = c >> 4, d0 = (c & 15) * 4; u32x2 v = {0u, 0u};
                        if (j < nrows) v = *(const u32x2*)(VG + (size_t)(row0 + j) * 256 + g * 64 + d0);
                        *(LAS bf16*)(lds + GV_OFF + (d0 + 0) * 272 + j * 2) = (bf16)(v.x & 0xffffu); *(LAS bf16*)(lds + GV_OFF + (d0 + 1) * 272 + j * 2) = (bf16)(v.x >> 16);
                        *(LAS bf16*)(lds + GV_OFF + (d0 + 2) * 272 + j * 2) = (bf16)(v.y & 0xffffu); *(LAS bf16*)(lds + GV_OFF + (d0 + 3) * 272 + j * 2) = (bf16)(v.y >> 16); }
                    __syncthreads();
                    if (wid * 16 < nrows) {
                        pg8::f32x4 acc[4];
#pragma unroll
                        for (int dt = 0; dt < 4; ++dt) acc[dt] = (pg8::f32x4){0.f, 0.f, 0.f, 0.f};
                        const int i = 16 * wid + (lane & 15), kb = lane >> 4, nks = (16 * wid + 15) / 32 + 1;
                        for (int ks = 0; ks < nks; ++ks) {
                            const bf16x8 a = *(const LAS bf16x8*)(lds + i * 272 + (32 * ks + 8 * kb) * 2); bf16x8 bfr[4];
#pragma unroll
                            for (int dt = 0; dt < 4; ++dt) bfr[dt] = *(const LAS bf16x8*)(lds + GV_OFF + (16 * dt + (lane & 15)) * 272 + (32 * ks + 8 * kb) * 2);
                            __builtin_amdgcn_sched_barrier(0);
#pragma unroll
                            for (int dt = 0; dt < 4; ++dt) acc[dt] = __builtin_amdgcn_mfma_f32_16x16x32_bf16(bfr[dt], a, acc[dt], 0, 0, 0);
                        }
                        const int ii = 16 * wid + (lane & 15); const float bsi = bsg[ii];
#pragma unroll
                        for (int dt = 0; dt < 4; ++dt) { const int d = 16 * dt + 4 * (lane >> 4);
                            const u32x2 uu = *(const u32x2*)(UG + (size_t)(row0 + ii) * 256 + g * 64 + d);
                            u32x2 w; w.x = pk2((acc[dt][0] + bsi) * bflo(uu.x), (acc[dt][1] + bsi) * bfhi(uu.x)); w.y = pk2((acc[dt][2] + bsi) * bflo(uu.y), (acc[dt][3] + bsi) * bfhi(uu.y));
                            *(u32x2*)(MIX + (size_t)(row0 + ii) * 1024 + g * 64 + d) = w; }
                    }
                    __syncthreads();
                }
            }
            const float* dww = P.in[13] + (size_t)l * 31 * 256; const float* dwb = P.in[14] + l * 256; const float* lng = P.in[15] + l * 256; const float* lnb = P.in[16] + l * 256;
            constexpr int CW_OFF = 65536;
            { f32x4 wv[4];
#pragma unroll
              for (int it = 0; it < 4; ++it) { const int c = tid + 512 * it; wv[it] = c < 31 * 64 ? *(const f32x4*)(dww + 4 * c) : (f32x4){0.f, 0.f, 0.f, 0.f}; }
#pragma unroll
              for (int it = 0; it < 4; ++it) { const int c = tid + 512 * it; if (c < 31 * 64) *(LAS f32x4*)(lds + CW_OFF + 16 * c) = wv[it]; } }
            __syncthreads();
            const f32x4 bias = *(const f32x4*)(dwb + 4 * lane), gg = *(const f32x4*)(lng + 4 * lane), bb = *(const f32x4*)(lnb + 4 * lane);
#pragma unroll 1
            for (int u0 = bid; u0 < 1024 + 256; u0 += G) {
                int u = u0;
                if (u0 >= 1024) { const int j = u0 - 1024; if (G == 256 ? (j < 216 || j >= 224) : (j >= 8)) continue; u = 1024 + (j & 7); }
                const bool samp = u >= 1024; const int b = samp ? u - 1024 : u >> 8; const int zrow0 = samp ? TP + 16 * b : b * 8192 + 32 * (u & 255);
                const int ntok = samp ? 16 : 32; const bool zero_hist = !samp && (u & 255) == 0; const float* hist = samp ? P.in[5] + (size_t)(l * 8 + b) * 30 * 256 : nullptr;
                const int nrows = 30 + ntok;
#pragma unroll 1
                for (int c = tid; c < nrows * 32; c += 512) { const int rr = c >> 5, cc = (c & 31) * 8; u32x4 v = {0u, 0u, 0u, 0u};
                    if (rr < 30) { if (hist) { const f32x4 a = *(const f32x4*)(hist + rr * 256 + cc), b2 = *(const f32x4*)(hist + rr * 256 + cc + 4); v.x = pk2(a[0], a[1]); v.y = pk2(a[2], a[3]); v.z = pk2(b2[0], b2[1]); v.w = pk2(b2[2], b2[3]); }
                                   else if (!zero_hist) v = *(const u32x4*)(Zb + (size_t)(zrow0 - 30 + rr) * 256 + cc); }
                    else v = *(const u32x4*)(Zb + (size_t)(zrow0 + rr - 30) * 256 + cc);
                    *(LAS u32x4*)(lds + rr * 512 + cc * 2) = v; }
                __syncthreads();
                {
                    const int tpw = ntok >> 3;
                    const int c4 = 4 * lane; f32x4 acc[4];
#pragma unroll
                    for (int j = 0; j < 4; ++j) acc[j] = bias;
#pragma unroll 4
                    for (int k = 0; k < 31; ++k) { const f32x4 w = *(const LAS f32x4*)(lds + CW_OFF + (k * 256 + c4) * 4);
#pragma unroll
                        for (int j = 0; j < 4; ++j) if (j < tpw) { const u32x2 z = *(const LAS u32x2*)(lds + (tpw * wid + j + k) * 512 + c4 * 2);
                            acc[j][0] += w[0] * bflo(z.x); acc[j][1] += w[1] * bfhi(z.x); acc[j][2] += w[2] * bflo(z.y); acc[j][3] += w[3] * bfhi(z.y); } }
#pragma unroll
                    for (int j = 0; j < 4; ++j) if (j < tpw) { const float mean = wave_sum((acc[j][0] + acc[j][1]) + (acc[j][2] + acc[j][3])) * (1.0f / 256.0f);
                        const f32x4 xc = acc[j] - mean; const float var = wave_sum((xc[0] * xc[0] + xc[1] * xc[1]) + (xc[2] * xc[2] + xc[3] * xc[3])) * (1.0f / 256.0f);
                        const float rs = rsqrtf(var + EPS); f32x4 y = xc * rs * gg + bb;
                        y[0] *= sigm_f(y[0]); y[1] *= sigm_f(y[1]); y[2] *= sigm_f(y[2]); y[3] *= sigm_f(y[3]);
                        u32x2 w2; w2.x = pk2(y[0], y[1]); w2.y = pk2(y[2], y[3]); *(u32x2*)(MIX + (size_t)(zrow0 + tpw * wid + j) * 1024 + 256 + c4) = w2; }
                }
                __syncthreads();
            }
        }

        if (false) {
            PHASE_IDS
            const float* gkn = P.in[23] + l * 64;
#pragma unroll 1
            for (int r = gw; r < LRV; r += NGW) {
                const u32x4 raw = *(const u32x4*)(KRAW + (size_t)r * 512 + 8 * lane);
                float x[8] = {bflo(raw.x), bfhi(raw.x), bflo(raw.y), bfhi(raw.y), bflo(raw.z), bfhi(raw.z), bflo(raw.w), bfhi(raw.w)};
                float s = 0.f;
#pragma unroll
                for (int j = 0; j < 8; ++j) s += x[j] * x[j];
                s = sum8(s);
                const float rs = rsqrtf(s * (1.0f / 64.0f) + EPS); const int hh = lane >> 3, d0 = 8 * (lane & 7);
                const f32x4 g0 = *(const f32x4*)(gkn + d0), g1 = *(const f32x4*)(gkn + d0 + 4);
                u32x4 w; w.x = pk2(x[0] * rs * g0[0], x[1] * rs * g0[1]); w.y = pk2(x[2] * rs * g0[2], x[3] * rs * g0[3]); w.z = pk2(x[4] * rs * g1[0], x[5] * rs * g1[1]); w.w = pk2(x[6] * rs * g1[2], x[7] * rs * g1[3]);
                bf16* dst;
                if (r < TP) { const int b = r >> 13, t = r & 8191; dst = KH + ((size_t)(b * 8 + hh) * 8192 + t) * 96; }
                else { const int rr = r - TP, b = rr / SKV, t = rr - b * SKV; dst = KHS + ((size_t)(b * 8 + hh) * KHS_T + t) * 96; }
                *(u32x4*)(dst + d0) = w;
                *(u32x2*)(dst + 64 + 4 * (lane & 7)) = *(const u32x2*)(KR + (size_t)r * 32 + 4 * (lane & 7));
            }
        }

        if (sp == 5 && EN_ATT) {
            PHASE_IDS
            const float* gqn = P.in[21] + l * 64; const float* gqr = P.in[22] + l * 32;
            const int r32 = lane & 31, hi = lane >> 5;
            const int vcu = (bid & 7) * 32 + (bid >> 3);
#pragma unroll 1
            for (int ui = 0;; ++ui) {
                int bh, qb;
                if (G == 256) { if (ui >= 4) break; const int xcd = bid & 7, v = bid >> 3, s = v & 15;
                    bh = 4 * xcd + 2 * (ui >> 1) + (v >> 4); qb = (ui & 1) ? 31 - s : s; }
                else { const int u = bid + ui * G; if (u >= 1024) break; bh = u >> 5; qb = u & 31; }
                const int b = bh >> 3, h = bh & 7; const int t = qb * 256 + wid * 32 + r32; const size_t row = (size_t)b * 8192 + t;
                bf16x8 q[6]; load_q_mla(q, QRAW + row * 768 + h * 96, hi, gqn, gqr, ROPE + (size_t)t * 32);
                f32x16 o[2]; float lsum;
                attn_block<96, 64>(ldc_, q, KH + (size_t)bh * 8192 * 96, VT + (size_t)(h * 64) * LR + (size_t)b * 8192, LR, 4 * qb + 4, 4 * qb + (wid >> 1) + 1, 1 << 30, o, lsum);
                attn_store<2>(o, lsum, MIX + row * 1024 + 512 + h * 64, hi, true);
            }
#pragma unroll 1
            for (int u = bid; u < 64; u += G) {
                const int b = u >> 3, h = u & 7, tq = min(r32, 15); const size_t row = (size_t)TP + b * 16 + tq;
                bf16x8 q[6]; load_q_mla(q, QRAW + row * 768 + h * 96, hi, gqn, gqr, ROPE + (size_t)(1024 + tq) * 32);
                f32x16 o[2]; float lsum;
                attn_block<96, 64>(ldc_, q, KHS + (size_t)(b * 8 + h) * KHS_T * 96, VT + (size_t)(h * 64) * LR + TP + b * SKV, LR, 17, wid == 0 ? 17 : 0, SKV, o, lsum);
                attn_store<2>(o, lsum, MIX + row * 1024 + 512 + h * 64, hi, wid == 0 && r32 < 16);
            }
        }

        if (sp == 8 && EN_MATT) {
            PHASE_IDS
            const float* gq = P.in[32] + l * 128; const int r32 = lane & 31, hi = lane >> 5;
#pragma unroll 1
            for (int u = bid; u < 512; u += G) {
                const int b = u >> 7, h = (u >> 5) & 3, qt = u & 31; const size_t row = (size_t)b * 8192 + qt * 256 + wid * 32 + r32;
                bf16x8 q[8]; load_q_mem(q, QMRAW + row * 512 + h * 128, hi, gq);
                f32x16 o[4]; float lsum;
                attn_block<128, 128>(ldc_, q, MK + (size_t)((l * 12 + b) * 4 + h) * 256 * 128, MVT + (size_t)((l * 12 + b) * 4 + h) * 128 * 256, 256, 4, 4, 1 << 30, o, lsum);
                attn_store<4>(o, lsum, OM + row * 512 + h * 128, hi, true);
            }
#pragma unroll 1
            for (int u = bid; u < 32; u += G) {
                const int b = u >> 2, h = u & 3, tq = min(r32, 15); const size_t row = (size_t)TP + b * 16 + tq;
                bf16x8 q[8]; load_q_mem(q, QMRAW + row * 512 + h * 128, hi, gq);
                f32x16 o[4]; float lsum;
                attn_block<128, 128>(ldc_, q, MK + (size_t)((l * 12 + 4 + b) * 4 + h) * 256 * 128, MVT + (size_t)((l * 12 + 4 + b) * 4 + h) * 128 * 256, 256, 4, wid == 0 ? 4 : 0, 256, o, lsum);
                attn_store<4>(o, lsum, OM + row * 512 + h * 128, hi, wid == 0 && r32 < 16);
            }
        }

        if (ph + 1 < P.ph_hi) { if (P.ph_hi > NPHASE) grid.sync(); else xcd_barrier(bar); }
#if REPEAT_SP
        if ((REPEAT_SP == 100 ? sp == 0 : sp == REPEAT_SP) && !redone) { redone = 1; --ph; } else redone = 0;
#endif
#if DOUBLE_SYNC
        if (ph + 1 < P.ph_hi) xcd_barrier(bar);
#endif
    }
}

#ifndef MULTI_LAUNCH
#define MULTI_LAUNCH 0
#endif
extern "C" void kernel_launch(void* const* d_in, const int* in_sizes, int n_in, void* d_out, int out_size, void* d_ws, size_t ws_size, hipStream_t stream) {
    static int grid = 0;
    if (grid == 0) {
        if (n_in != 37 || out_size != (int)O_END || ws_size < WS_END) { fprintf(stderr, "kernel_launch: unexpected shapes n_in %d out %d ws %zu (need %zu)\n", n_in, out_size, ws_size, (size_t)WS_END); grid = -1; return; }
        int dev = 0, cus = 0, per_cu = 0;
        hipGetDevice(&dev); hipDeviceGetAttribute(&cus, hipDeviceAttributeMultiprocessorCount, dev);
        hipFuncSetAttribute((const void*)fwd_kernel, hipFuncAttributeMaxDynamicSharedMemorySize, LDS_BYTES);
        hipOccupancyMaxActiveBlocksPerMultiprocessor(&per_cu, (const void*)fwd_kernel, 512, LDS_BYTES);
        if (per_cu < 1) per_cu = 1;
        (void)hipGetLastError();
        grid = cus * per_cu;
        if (grid > 256) grid = 256;
    }
    if (grid < 0) return;
    if (hipMemsetAsync((char*)d_ws + OFF_CTL, 0, CTL_BYTES, stream) != hipSuccess) { fprintf(stderr, "kernel_launch: memset failed\n"); return; }
    Params p{};
    for (int i = 0; i < 37; ++i) p.in[i] = (const float*)d_in[i];
    p.out = (float*)d_out; p.ws = (unsigned char*)d_ws;
#if MULTI_LAUNCH
    for (int ph = 0; ph < NPHASE; ++ph) { p.ph_lo = ph; p.ph_hi = ph + 1; hipLaunchKernelGGL(fwd_kernel, dim3(grid), dim3(512), LDS_BYTES, stream, p); }
#else
    p.ph_lo = 0; p.ph_hi = NPHASE;
    void* args[] = {&p};
    hipError_t e = hipLaunchCooperativeKernel((const void*)fwd_kernel, dim3(grid), dim3(512), args, LDS_BYTES, stream);
    if (e != hipSuccess) fprintf(stderr, "cooperative launch failed: %s (grid %d)\n", hipGetErrorString(e), grid);
#endif
}
```
